# Optimizing an MI355X kernel written in HIP

```python
import math
import jax, jax.numpy as jnp
from jax import lax
import numpy as np

D_MODEL = 1024
BATCH = 2
SEQ = 8192
DEPTH = 1

EPS = 1e-6
D_MIX = D_MODEL
RET_HEADS = 4
RET_DK = 128
RET_DV = 128
RET_WIDTH = RET_HEADS * RET_DV
RET_CHUNK = 128
RET_ROPE_THETA = 10000.0
DIFF_HEADS = 4
DIFF_DH = 64
DIFF_DV = 2 * DIFF_DH
DIFF_WIDTH = DIFF_HEADS * DIFF_DV
Q_BLOCK = 128
ROPE_THETA = 500000.0
ROT_DIM = DIFF_DH // 4
RET_Q = RET_HEADS * RET_DK
RET_K = RET_HEADS * RET_DK
RET_V = RET_HEADS * RET_DV
RET_G = RET_WIDTH
DIFF_Q = DIFF_HEADS * 2 * DIFF_DH
DIFF_K = DIFF_HEADS * 2 * DIFF_DH
DIFF_V = DIFF_HEADS * DIFF_DV
SPLITS = [RET_Q, RET_K, RET_V, RET_G, DIFF_Q, DIFF_K, DIFF_V]
D_IN_PROJ = sum(SPLITS)
N_EXPERTS = 32
TOP_K = 4
D_FF = D_MODEL
SWIGLU_LIMIT = 7.0
SWIGLU_ALPHA = 1.702
MOE_BLOCK = 128

kernel_name = "hybrid_retention_diffattn_moe_encoder"


def rms_norm(x, w):
    xf = x.astype(jnp.float32)
    y = xf * lax.rsqrt(jnp.mean(xf * xf, axis=-1, keepdims=True) + EPS)
    return (y * w.astype(jnp.float32)).astype(x.dtype)


def rotary_cos_sin(positions, inv_freq):
    ang = positions.astype(jnp.float32)[..., None] * inv_freq
    return jnp.cos(ang), jnp.sin(ang)


def apply_rotary(x, cos, sin):
    xf = x.astype(jnp.float32)
    half = xf.shape[-1] // 2
    x1, x2 = xf[..., :half], xf[..., half:]
    out = jnp.concatenate([x1 * cos - x2 * sin, x2 * cos + x1 * sin], axis=-1)
    return out.astype(x.dtype)


def retention_one_direction(q, k, v, log_decay, include_diag):
    B, H, S, dk = q.shape
    dv = v.shape[-1]
    C = RET_CHUNK
    NC = S // C
    qc = q.reshape(B, H, NC, C, dk)
    kc = k.reshape(B, H, NC, C, dk)
    vc = v.reshape(B, H, NC, C, dv)
    idx = jnp.arange(C, dtype=jnp.float32)
    dist = idx[:, None] - idx[None, :]
    mask = (dist >= 0) if include_diag else (dist > 0)
    ld = log_decay.astype(jnp.float32)
    decay_mat = jnp.where(mask[None], jnp.exp(ld[:, None, None] * jnp.where(mask, dist, 0.0)[None]), 0.0)
    scores = jnp.einsum("bhcnd,bhcmd->bhcnm", qc, kc) * decay_mat[None, :, None]
    intra = jnp.einsum("bhcnm,bhcme->bhcne", scores, vc)
    k_decay = jnp.exp(ld[:, None] * (C - 1 - idx)[None])
    kv = jnp.einsum("bhcmd,hm,bhcme->bhcde", kc, k_decay, vc)
    chunk_decay = jnp.exp(ld * C)[None, :, None, None]

    def step(state, kv_i):
        return state * chunk_decay + kv_i, state

    _, prev = lax.scan(step, jnp.zeros((B, H, dk, dv), jnp.float32), jnp.moveaxis(kv, 2, 0))
    prev = jnp.moveaxis(prev, 0, 2)
    q_decay = jnp.exp(ld[:, None] * (idx + 1.0)[None])
    cross = jnp.einsum("bhcnd,bhcde->bhcne", qc, prev) * q_decay[None, :, None, :, None]
    return (intra + cross).reshape(B, H, S, dv)


def retention_group(q_raw, k_raw, v_raw, g_raw, positions, log_decay_fwd, log_decay_bwd, norm_w):
    B, S, _ = q_raw.shape
    inv_freq = RET_ROPE_THETA ** (-jnp.linspace(0.0, 1.0, RET_DK // 2, dtype=jnp.float32))
    cos, sin = rotary_cos_sin(positions, inv_freq)
    cos, sin = cos[:, :, None, :], sin[:, :, None, :]
    q = apply_rotary(q_raw.reshape(B, S, RET_HEADS, RET_DK), cos, sin)
    k = apply_rotary(k_raw.reshape(B, S, RET_HEADS, RET_DK), cos, sin) * (RET_DK ** -0.5)
    v = v_raw.reshape(B, S, RET_HEADS, RET_DV)
    q = jnp.transpose(q, (0, 2, 1, 3)).astype(jnp.float32)
    k = jnp.transpose(k, (0, 2, 1, 3)).astype(jnp.float32)
    v = jnp.transpose(v, (0, 2, 1, 3)).astype(jnp.float32)
    y_fwd = retention_one_direction(q, k, v, log_decay_fwd, True)
    y_bwd = jnp.flip(retention_one_direction(jnp.flip(q, 2), jnp.flip(k, 2), jnp.flip(v, 2), log_decay_bwd, False), 2)
    y = jnp.transpose(y_fwd + y_bwd, (0, 2, 1, 3))
    y = rms_norm(y, norm_w.reshape(RET_HEADS, RET_DV))
    y = y.reshape(B, S, RET_WIDTH) * jax.nn.silu(g_raw.astype(jnp.float32))
    return y.astype(q_raw.dtype)


def diff_attention_group(q_raw, k_raw, v_raw, positions, q_norm_w, k_norm_w,
                         lq1, lk1, lq2, lk2, sub_norm_w, lambda_init):
    B, S, _ = q_raw.shape
    q = rms_norm(q_raw.reshape(B, S, DIFF_HEADS, 2, DIFF_DH), q_norm_w)
    k = rms_norm(k_raw.reshape(B, S, DIFF_HEADS, 2, DIFF_DH), k_norm_w)
    inv_freq = ROPE_THETA ** (-jnp.arange(0, ROT_DIM, 2, dtype=jnp.float32) / ROT_DIM)
    cos, sin = rotary_cos_sin(positions, inv_freq)
    cos, sin = cos[:, :, None, None, :], sin[:, :, None, None, :]
    q = jnp.concatenate([apply_rotary(q[..., :ROT_DIM], cos, sin), q[..., ROT_DIM:]], axis=-1)
    k = jnp.concatenate([apply_rotary(k[..., :ROT_DIM], cos, sin), k[..., ROT_DIM:]], axis=-1)
    q = jnp.transpose(q, (0, 2, 3, 1, 4))
    k = jnp.transpose(k, (0, 2, 3, 1, 4))
    v = jnp.transpose(v_raw.reshape(B, S, DIFF_HEADS, DIFF_DV), (0, 2, 1, 3)).astype(jnp.float32)
    lam = (jnp.exp(jnp.sum(lq1.astype(jnp.float32) * lk1.astype(jnp.float32)))
           - jnp.exp(jnp.sum(lq2.astype(jnp.float32) * lk2.astype(jnp.float32))) + lambda_init)
    scale = DIFF_DH ** -0.5
    n_blocks = S // Q_BLOCK
    q_blocks = jnp.moveaxis(q.reshape(B, DIFF_HEADS, 2, n_blocks, Q_BLOCK, DIFF_DH), 3, 0)

    def attend(q_blk):
        s = jnp.einsum("bhcqd,bhckd->bhcqk", q_blk, k).astype(jnp.float32) * scale
        p = jax.nn.softmax(s, axis=-1)
        a = p[:, :, 0] - lam * p[:, :, 1]
        return jnp.einsum("bhqk,bhkd->bhqd", a, v)

    o = lax.map(attend, q_blocks)
    o = jnp.transpose(o, (1, 0, 3, 2, 4)).reshape(B, S, DIFF_HEADS, DIFF_DV)
    o = rms_norm(o, sub_norm_w) * (1.0 - lambda_init)
    return o.reshape(B, S, DIFF_WIDTH).astype(q_raw.dtype)


def moe_ffn(h, w_router, b_router, w1, b1, w2, b2):
    B, S, D = h.shape
    T = B * S
    ht = h.reshape(T, D)
    logits = (ht @ w_router + b_router).astype(jnp.float32)
    top_val, top_idx = lax.top_k(logits, TOP_K)
    gates = jax.nn.softmax(top_val, axis=-1)
    A = T * TOP_K
    e_flat = top_idx.reshape(A).astype(jnp.int32)
    tok_flat = jnp.arange(A, dtype=jnp.int32) // TOP_K
    g_flat = gates.reshape(A)
    order = jnp.argsort(e_flat, stable=True)
    e_sorted, tok_sorted, g_sorted = e_flat[order], tok_flat[order], g_flat[order]
    counts = jnp.zeros((N_EXPERTS,), jnp.int32).at[e_flat].add(1)
    starts = jnp.cumsum(counts) - counts
    padded = ((counts + MOE_BLOCK - 1) // MOE_BLOCK) * MOE_BLOCK
    pad_end = jnp.cumsum(padded)
    pad_start = pad_end - padded
    dest = pad_start[e_sorted] + (jnp.arange(A, dtype=jnp.int32) - starts[e_sorted])
    P = A + N_EXPERTS * MOE_BLOCK
    NB = P // MOE_BLOCK
    tok_buf = jnp.full((P,), T, jnp.int32).at[dest].set(tok_sorted)
    gate_buf = jnp.zeros((P,), jnp.float32).at[dest].set(g_sorted)
    block_e = jnp.minimum(jnp.searchsorted(pad_end, jnp.arange(NB, dtype=jnp.int32) * MOE_BLOCK, side="right"),
                          N_EXPERTS - 1).astype(jnp.int32)
    h_pad = jnp.concatenate([ht, jnp.zeros((1, D), ht.dtype)], axis=0)
    x_blocks = h_pad[tok_buf].reshape(NB, MOE_BLOCK, D)

    def expert_block(args):
        xb, e = args
        u = xb @ w1[e] + b1[e]
        glu = jnp.minimum(u[:, :D_FF], SWIGLU_LIMIT)
        lin = jnp.clip(u[:, D_FF:], -SWIGLU_LIMIT, SWIGLU_LIMIT)
        act = glu * jax.nn.sigmoid(SWIGLU_ALPHA * glu) * (lin + 1.0)
        return act @ w2[e] + b2[e]

    y_blocks = lax.map(expert_block, (x_blocks, block_e))
    y = y_blocks.reshape(P, D).astype(jnp.float32) * gate_buf[:, None]
    out = jax.ops.segment_sum(y, tok_buf, num_segments=T + 1)[:T]
    return out.reshape(B, S, D).astype(h.dtype)


def setup_inputs(seed: int = 0) -> dict:
    key = jax.random.key(seed)
    ks = jax.random.split(key, 24)
    f32 = jnp.float32
    nrm = lambda k, shape, s: jax.random.normal(k, shape, f32) * s
    x = jax.random.normal(ks[0], (BATCH, SEQ, D_MODEL), f32)
    offsets = jax.random.randint(ks[1], (BATCH, 1), 0, 1024, dtype=jnp.int32)
    positions = (jnp.arange(SEQ, dtype=jnp.int32)[None, :] + offsets).astype(jnp.int32)
    base_decay = jnp.log(1.0 - 2.0 ** (-5.0 - jnp.arange(RET_HEADS, dtype=f32)))
    ret_log_decay_fwd = base_decay[None] * (1.0 + 0.05 * jax.random.normal(ks[2], (DEPTH, RET_HEADS), f32))
    ret_log_decay_bwd = base_decay[None] * (1.0 + 0.05 * jax.random.normal(ks[3], (DEPTH, RET_HEADS), f32))
    return {
        "x": x,
        "positions": positions,
        "norm1_w": 1.0 + nrm(ks[4], (DEPTH, D_MODEL), 0.02),
        "w_in": nrm(ks[5], (DEPTH, D_MODEL, D_IN_PROJ), D_MODEL ** -0.5),
        "ret_log_decay_fwd": ret_log_decay_fwd,
        "ret_log_decay_bwd": ret_log_decay_bwd,
        "ret_norm_w": 1.0 + nrm(ks[6], (DEPTH, RET_WIDTH), 0.02),
        "q_norm_w": 1.0 + nrm(ks[7], (DEPTH, DIFF_DH), 0.02),
        "k_norm_w": 1.0 + nrm(ks[8], (DEPTH, DIFF_DH), 0.02),
        "lambda_q1": nrm(ks[9], (DEPTH, DIFF_DH), 0.1),
        "lambda_k1": nrm(ks[10], (DEPTH, DIFF_DH), 0.1),
        "lambda_q2": nrm(ks[11], (DEPTH, DIFF_DH), 0.1),
        "lambda_k2": nrm(ks[12], (DEPTH, DIFF_DH), 0.1),
        "diff_norm_w": 1.0 + nrm(ks[13], (DEPTH, DIFF_DV), 0.02),
        "w_out": nrm(ks[14], (DEPTH, D_MIX, D_MODEL), D_MIX ** -0.5),
        "norm2_w": 1.0 + nrm(ks[15], (DEPTH, D_MODEL), 0.02),
        "w_router": nrm(ks[16], (DEPTH, D_MODEL, N_EXPERTS), D_MODEL ** -0.5),
        "b_router": nrm(ks[17], (DEPTH, N_EXPERTS), 0.01),
        "w1": nrm(ks[18], (DEPTH, N_EXPERTS, D_MODEL, 2 * D_FF), D_MODEL ** -0.5),
        "b1": nrm(ks[19], (DEPTH, N_EXPERTS, 2 * D_FF), 0.01),
        "w2": nrm(ks[20], (DEPTH, N_EXPERTS, D_FF, D_MODEL), D_FF ** -0.5),
        "b2": nrm(ks[21], (DEPTH, N_EXPERTS, D_MODEL), 0.01),
    }


def reference(x, positions, norm1_w, w_in, ret_log_decay_fwd, ret_log_decay_bwd, ret_norm_w,
              q_norm_w, k_norm_w, lambda_q1, lambda_k1, lambda_q2, lambda_k2, diff_norm_w,
              w_out, norm2_w, w_router, b_router, w1, b1, w2, b2):
    split_points = list(np.cumsum(SPLITS)[:-1])
    for l in range(DEPTH):
        lambda_init = 0.8 - 0.6 * math.exp(-0.3 * l)
        h = rms_norm(x, norm1_w[l])
        proj = h @ w_in[l]
        rq, rk, rv, rg, dq, dk, dv = jnp.split(proj, split_points, axis=-1)
        y_ret = retention_group(rq, rk, rv, rg, positions, ret_log_decay_fwd[l], ret_log_decay_bwd[l], ret_norm_w[l])
        y_diff = diff_attention_group(dq, dk, dv, positions, q_norm_w[l], k_norm_w[l],
                                      lambda_q1[l], lambda_k1[l], lambda_q2[l], lambda_k2[l],
                                      diff_norm_w[l], lambda_init)
        mixed = jnp.concatenate([y_ret, y_diff], axis=-1)
        x = x + (mixed @ w_out[l]).astype(x.dtype)
        h2 = rms_norm(x, norm2_w[l])
        x = x + moe_ffn(h2, w_router[l], b_router[l], w1[l], b1[l], w2[l], b2[l])
    return x
```

```cpp
#include <hip/hip_runtime.h>
#include <hip/hip_bf16.h>
#include <cstdio>
#include <cstdint>
#include <cmath>
#ifndef MK_SPLIT
#define MK_SPLIT 0
#endif
__device__ __forceinline__ int ltid() { int t = (int)threadIdx.x; asm volatile("" : "+v"(t)); return t; }
namespace pg8 {
#define PG8_LAS __attribute__((address_space(3)))
typedef unsigned short bf16_t;
typedef short bf16x8 __attribute__((ext_vector_type(8)));
typedef float f32x4 __attribute__((ext_vector_type(4)));
typedef unsigned u32x4 __attribute__((ext_vector_type(4)));
constexpr int BM = 256, BK = 64, HALF = 128, HTB = HALF * BK * 2  , STAGE_BYTES = 8 * HTB, NXCD = 8, WGM = 8;

__host__ __device__ __forceinline__ int lds_byte(int r, int c) { const int st = (r >> 4) * 2 + (c >> 5), rr = r & 15, cc = c & 31, ob = rr * 64 + cc * 2; return st * 1024 + (ob ^ (((ob >> 9) & 1) << 5)); }
__host__ __device__ __forceinline__ void stage_rc(int b, int& R, int& C) { const int st = b / 1024, sb = b % 1024, swz = sb ^ (((sb >> 9) & 1) << 5); R = (st >> 1) * 16 + swz / 64; C = (st & 1) * 32 + (swz % 64) / 2; }
__host__ __device__ __forceinline__ int perm32(int rho) { const int n = rho >> 4, i = rho & 15; return 8 * (i >> 2) + 4 * n + (i & 3); }

struct Unit { int pm, pn; };
struct Gemm { const bf16_t* A; const bf16_t* Bt; int M, N, K; };

struct StaticOrder {
    int nM, nN, nwg, G, c;
    __host__ __device__ void init(int M, int N, int G_, int c_) { nM = M / BM; nN = N / BM; nwg = nM * nN; G = G_; c = c_; }
    __host__ __device__ bool next(int i, Unit& u) const {
        const long L = (long)i * G + c; if (L >= nwg) return false;
        int wgid = (int)L; { const int q = nwg / NXCD, r = nwg % NXCD, xcd = wgid % NXCD, off = wgid / NXCD; wgid = (xcd < r ? xcd * (q + 1) : r * (q + 1) + (xcd - r) * q) + off; }
        const int nig = WGM * nN, gid = wgid / nig, fm = gid * WGM, gsz = (nM - fm) < WGM ? (nM - fm) : WGM;
        u.pm = fm + ((wgid % nig) % gsz); u.pn = (wgid % nig) / gsz; return true;
    }
    __device__ __forceinline__ void a_ready(const Unit&) const {}
    __device__ __forceinline__ void done(const Unit&) const {}
};

__device__ __forceinline__ unsigned cvt_pk_bf16(float lo, float hi) { unsigned r; asm volatile("v_cvt_pk_bf16_f32 %0, %1, %2" : "=v"(r) : "v"(lo), "v"(hi)); return r; }
typedef float f32x2 __attribute__((ext_vector_type(2)));
struct EpiStoreBf16 {
    static constexpr bool PERM = true, AFTER_DRAIN = false;
    bf16_t* O; int ldc;
    __device__ __forceinline__ void operator()(const f32x4 (&acc)[2][2][4][2], const Unit& u, int wr, int wc, int fr, int fq) const {
        const int row0 = u.pm * BM + wr * 64 + fr, col0 = u.pn * BM + wc * 32 + 8 * fq;
#pragma unroll
        for (int ai = 0; ai < 2; ++ai)
#pragma unroll
            for (int m = 0; m < 4; ++m) { bf16_t* rowp = O + (size_t)(row0 + ai * HALF + m * 16) * ldc + col0;
#pragma unroll
                for (int bj = 0; bj < 2; ++bj) { const f32x4 v0 = acc[ai][bj][m][0], v1 = acc[ai][bj][m][1];
                    u32x4 w; w.x = cvt_pk_bf16(v0[0], v0[1]); w.y = cvt_pk_bf16(v0[2], v0[3]); w.z = cvt_pk_bf16(v1[0], v1[1]); w.w = cvt_pk_bf16(v1[2], v1[3]);
                    *(u32x4*)(rowp + bj * HALF) = w; } }
    }
};
struct EpiResF32 {
    static constexpr bool PERM = false, AFTER_DRAIN = false;
    const float* base; float* out; int ldc;
    __device__ __forceinline__ void operator()(const f32x4 (&acc)[2][2][4][2], const Unit& u, int wr, int wc, int fr, int fq) const {
        const int row0 = u.pm * BM + wr * 64 + fr, col0 = u.pn * BM + wc * 32 + 4 * fq;
#pragma unroll
        for (int ai = 0; ai < 2; ++ai)
#pragma unroll
            for (int m = 0; m < 4; ++m) { const size_t off = (size_t)(row0 + ai * HALF + m * 16) * ldc + col0;
#pragma unroll
                for (int bj = 0; bj < 2; ++bj)
#pragma unroll
                    for (int n = 0; n < 2; ++n) { const f32x4 bs = *(const f32x4*)(base + off + bj * HALF + n * 16); *(f32x4*)(out + off + bj * HALF + n * 16) = bs + acc[ai][bj][m][n]; } }
    }
};
struct EpiSwiglu {
    static constexpr bool PERM = true, AFTER_DRAIN = false;
    bf16_t* ACT; const float* b1;
    __device__ __forceinline__ void operator()(const f32x4 (&acc)[2][2][4][2], const Unit& u, int wr, int wc, int fr, int fq) const {
        const int e = u.pn >> 3, pnl = u.pn & 7, colact0 = pnl * 128 + wc * 32 + 8 * fq;
        const int row0 = u.pm * BM + wr * 64 + fr;
        f32x4 bg[2], bl[2];
#pragma unroll
        for (int n = 0; n < 2; ++n) { bg[n] = *(const f32x4*)(b1 + (size_t)e * 2048 + colact0 + 4 * n); bl[n] = *(const f32x4*)(b1 + (size_t)e * 2048 + 1024 + colact0 + 4 * n); }
#pragma unroll
        for (int ai = 0; ai < 2; ++ai)
#pragma unroll
            for (int m = 0; m < 4; ++m) { float a[8];
#pragma unroll
                for (int n = 0; n < 2; ++n) { const f32x4 g4 = acc[ai][0][m][n] + bg[n], l4 = acc[ai][1][m][n] + bl[n];
#pragma unroll
                    for (int i = 0; i < 4; ++i) { const float g = fminf(g4[i], 7.0f), l = fminf(fmaxf(l4[i], -7.0f), 7.0f);
                        const float sg = __builtin_amdgcn_rcpf(1.0f + __builtin_amdgcn_exp2f(-1.702f * 1.4426950408889634f * g));
                        a[4 * n + i] = g * sg * (l + 1.0f); } }
                u32x4 w; w.x = cvt_pk_bf16(a[0], a[1]); w.y = cvt_pk_bf16(a[2], a[3]); w.z = cvt_pk_bf16(a[4], a[5]); w.w = cvt_pk_bf16(a[6], a[7]);
                *(u32x4*)(ACT + (size_t)(row0 + ai * HALF + m * 16) * 1024 + colact0) = w; }
    }
};
struct EpiGateBf16 {
    static constexpr bool PERM = true, AFTER_DRAIN = false;
    bf16_t* Y; const float* b2; const float* gatep;
    __device__ __forceinline__ void operator()(const f32x4 (&acc)[2][2][4][2], const Unit& u, int wr, int wc, int fr, int fq) const {
        const int e = u.pn >> 2, pnl = u.pn & 3, col0 = pnl * BM + wc * 32 + 8 * fq;
        const int row0 = u.pm * BM + wr * 64 + fr;
        f32x4 bv[2][2];
#pragma unroll
        for (int bj = 0; bj < 2; ++bj)
#pragma unroll
            for (int n = 0; n < 2; ++n) bv[bj][n] = *(const f32x4*)(b2 + (size_t)e * 1024 + col0 + bj * HALF + 4 * n);
#pragma unroll
        for (int ai = 0; ai < 2; ++ai)
#pragma unroll
            for (int m = 0; m < 4; ++m) { const int row = row0 + ai * HALF + m * 16; const float g = gatep[row];
#pragma unroll
                for (int bj = 0; bj < 2; ++bj) { const f32x4 v0 = (acc[ai][bj][m][0] + bv[bj][0]) * g, v1 = (acc[ai][bj][m][1] + bv[bj][1]) * g;
                    u32x4 w; w.x = cvt_pk_bf16(v0[0], v0[1]); w.y = cvt_pk_bf16(v0[2], v0[3]); w.z = cvt_pk_bf16(v1[0], v1[1]); w.w = cvt_pk_bf16(v1[2], v1[3]);
                    *(u32x4*)(Y + (size_t)row * 1024 + col0 + bj * HALF) = w; } }
    }
};
struct MoeOrder {
    int nunits, npn, G, c; const PG8_LAS unsigned char* tile_e;
    __device__ __forceinline__ bool next(int i, Unit& u) const {
        const long L = (long)i * G + c; if (L >= nunits) return false;
        const int tm = (int)L / npn, j = (int)L % npn; u.pm = tm; u.pn = (int)tile_e[tm] * npn + j; return true;
    }
    __device__ __forceinline__ void a_ready(const Unit&) const {}
    __device__ __forceinline__ void done(const Unit&) const {}
};
template <class Epi, class Sched, bool ALIGN_EPI = false, bool SP2 = false>
__device__ __forceinline__ void gemm_phase(PG8_LAS unsigned char* lds, const Gemm g, const Sched& S, const Epi& E) {
    const int tid = ltid(), wid = __builtin_amdgcn_readfirstlane(tid >> 6), lane = tid & 63, wr = wid >> 2, wc = wid & 3, fr = lane & 15, fq = lane >> 4;
    const int K = g.K, nt = K / BK;
    unsigned voffA[2], voffB[2];
#pragma unroll
    for (int i = 0; i < 2; ++i) { int R, C; stage_rc(tid * 16 + i * 8192, R, C); const int Rb = Epi::PERM ? ((R & ~31) + perm32(R & 31)) : R;
        voffA[i] = (unsigned)(R * K + C) * 2u; voffB[i] = (unsigned)(Rb * K + C) * 2u; }
    const size_t kstep = (size_t)(BK * 2);
    const size_t hstep = (size_t)HALF * K * 2;
    const size_t tstep = 2 * hstep;
    const unsigned ldsw = (unsigned)wid * 1024u;
    const int aoff = lds_byte(wr * 64 + fr, fq * 8), boff = lds_byte(wc * 32 + fr, fq * 8);
#define PG8_SA(b, h) (((b) * 2 + (h)) * HTB)
#define PG8_SB(b, h) ((4 + (b) * 2 + (h)) * HTB)
#define PG8_STAGE(bufoff, gbase, voff) do { _Pragma("unroll") for (int _i = 0; _i < 2; ++_i) \
        __builtin_amdgcn_global_load_lds((const unsigned*)((const char*)(gbase) + (voff)[_i]), (PG8_LAS unsigned*)(lds + (bufoff) + ldsw + _i * 8192), 16, 0, 0); } while (0)
#define PG8_LDA(dst, b, h) do { _Pragma("unroll") for (int m = 0; m < 4; ++m) _Pragma("unroll") for (int k = 0; k < 2; ++k) dst[m][k] = *(const PG8_LAS bf16x8*)(lds + PG8_SA(b, h) + aoff + m * 2048 + k * 1024); } while (0)
#define PG8_LDB(dst, b, h) do { _Pragma("unroll") for (int n = 0; n < 2; ++n) _Pragma("unroll") for (int k = 0; k < 2; ++k) dst[n][k] = *(const PG8_LAS bf16x8*)(lds + PG8_SB(b, h) + boff + n * 2048 + k * 1024); } while (0)
#define PG8_MMA(ai, bj, At, Bt) do { __builtin_amdgcn_s_setprio(1); _Pragma("unroll") for (int m = 0; m < 4; ++m) _Pragma("unroll") for (int n = 0; n < 2; ++n) _Pragma("unroll") for (int k = 0; k < 2; ++k) \
        acc[ai][bj][m][n] = __builtin_amdgcn_mfma_f32_16x16x32_bf16(Bt[n][k], At[m][k], acc[ai][bj][m][n], 0, 0, 0); __builtin_amdgcn_s_setprio(0); } while (0)
#define PG8_WAIT_V(n) asm volatile("s_waitcnt vmcnt(" #n ")" ::: "memory")
#define PG8_WAIT_L(n) asm volatile("s_waitcnt lgkmcnt(" #n ")" ::: "memory")
#define PG8_BAR __builtin_amdgcn_s_barrier()
#define PG8_SCHED __builtin_amdgcn_sched_barrier(0)
    Unit cur, nxt; int ui = 0;
    if (!S.next(0, cur)) return;
    f32x4 acc[2][2][4][2];
#pragma unroll
    for (int a = 0; a < 2; ++a)
#pragma unroll
        for (int b = 0; b < 2; ++b)
#pragma unroll
            for (int m = 0; m < 4; ++m)
#pragma unroll
                for (int n = 0; n < 2; ++n) acc[a][b][m][n] = (f32x4){0.f, 0.f, 0.f, 0.f};
    bf16x8 At[4][2], B0[2][2], B1[2][2];
    const char* cA = (const char*)g.A + (size_t)cur.pm * tstep; const char* cB = (const char*)g.Bt + (size_t)cur.pn * tstep;
    S.a_ready(cur);
    if constexpr (SP2) {
        PG8_STAGE(PG8_SB(0, 0), cB, voffB); PG8_STAGE(PG8_SB(0, 1), cB + hstep, voffB); PG8_STAGE(PG8_SA(0, 0), cA, voffA); PG8_STAGE(PG8_SA(0, 1), cA + hstep, voffA);
        if (wr == 1) PG8_BAR;
        PG8_WAIT_V(2); PG8_BAR;
        PG8_STAGE(PG8_SB(1, 0), cB + kstep, voffB); PG8_STAGE(PG8_SA(1, 0), cA + kstep, voffA); PG8_STAGE(PG8_SB(1, 1), cB + hstep + kstep, voffB);
        PG8_WAIT_V(6); PG8_BAR;
    } else {
        PG8_STAGE(PG8_SB(0, 0), cB, voffB); PG8_STAGE(PG8_SA(0, 0), cA, voffA); PG8_STAGE(PG8_SB(0, 1), cB + hstep, voffB); PG8_STAGE(PG8_SA(0, 1), cA + hstep, voffA);
        if (wr == 1) PG8_BAR;
        PG8_WAIT_V(4); PG8_BAR;
        PG8_STAGE(PG8_SB(1, 0), cB + kstep, voffB); PG8_STAGE(PG8_SA(1, 0), cA + kstep, voffA); PG8_STAGE(PG8_SB(1, 1), cB + hstep + kstep, voffB);
        PG8_WAIT_V(6); PG8_BAR;
    }
    for (;;) {
        const bool has_next = S.next(ui + 1, nxt);
        const char* nA = has_next ? (const char*)g.A + (size_t)nxt.pm * tstep : cA; const char* nB = has_next ? (const char*)g.Bt + (size_t)nxt.pn * tstep : cB;
        for (int t = 0; t < nt; t += 2) {
            const bool last = (t == nt - 2);
            const char* a1 = cA + (size_t)(t + 1) * kstep;
            const char* a2 = last ? nA : cA + (size_t)(t + 2) * kstep; const char* b2 = last ? nB : cB + (size_t)(t + 2) * kstep;
            const char* a3 = a2 + kstep; const char* b3 = b2 + kstep;
            if (last && has_next) S.a_ready(nxt);
            if constexpr (SP2) {
            PG8_LDB(B0, 0, 0); PG8_LDB(B1, 0, 1); PG8_SCHED; PG8_LDA(At, 0, 0); PG8_STAGE(PG8_SA(1, 1), a1 + hstep, voffA);
            PG8_WAIT_V(8); PG8_WAIT_L(0); PG8_BAR; PG8_MMA(0, 0, At, B0); PG8_MMA(0, 1, At, B1); PG8_BAR; PG8_SCHED;
            PG8_LDA(At, 0, 1); PG8_STAGE(PG8_SB(0, 0), b2, voffB); PG8_STAGE(PG8_SB(0, 1), b2 + hstep, voffB); PG8_STAGE(PG8_SA(0, 0), a2, voffA);
            PG8_WAIT_V(8); PG8_WAIT_L(0); PG8_BAR; PG8_MMA(1, 0, At, B0); PG8_MMA(1, 1, At, B1); PG8_BAR; PG8_SCHED;
            PG8_LDB(B0, 1, 0); PG8_LDB(B1, 1, 1); PG8_SCHED; PG8_LDA(At, 1, 0); PG8_STAGE(PG8_SA(0, 1), a2 + hstep, voffA);
            PG8_WAIT_V(8); PG8_WAIT_L(0); PG8_BAR; PG8_MMA(0, 0, At, B0); PG8_MMA(0, 1, At, B1); PG8_BAR; PG8_SCHED;
            PG8_LDA(At, 1, 1); PG8_STAGE(PG8_SB(1, 0), b3, voffB); PG8_STAGE(PG8_SB(1, 1), b3 + hstep, voffB); PG8_STAGE(PG8_SA(1, 0), a3, voffA);
            PG8_WAIT_V(8); PG8_WAIT_L(0); PG8_BAR; PG8_MMA(1, 0, At, B0); PG8_MMA(1, 1, At, B1); PG8_BAR; PG8_SCHED;
            } else {
            PG8_LDB(B0, 0, 0); PG8_SCHED; PG8_LDA(At, 0, 0); PG8_STAGE(PG8_SA(1, 1), a1 + hstep, voffA);
            PG8_WAIT_L(8); PG8_BAR; PG8_WAIT_L(0); PG8_MMA(0, 0, At, B0); PG8_BAR; PG8_SCHED;
            PG8_LDB(B1, 0, 1); PG8_STAGE(PG8_SB(0, 0), b2, voffB);
            PG8_BAR; PG8_WAIT_L(0); PG8_MMA(0, 1, At, B1); PG8_BAR;
            PG8_LDA(At, 0, 1); PG8_STAGE(PG8_SA(0, 0), a2, voffA);
            PG8_BAR; PG8_WAIT_L(0); PG8_MMA(1, 0, At, B0); PG8_BAR; PG8_SCHED;
            PG8_STAGE(PG8_SB(0, 1), b2 + hstep, voffB);
            PG8_WAIT_V(6); PG8_BAR; PG8_MMA(1, 1, At, B1); PG8_BAR;
            PG8_LDB(B0, 1, 0); PG8_SCHED; PG8_LDA(At, 1, 0); PG8_STAGE(PG8_SA(0, 1), a2 + hstep, voffA);
            PG8_WAIT_L(8); PG8_BAR; PG8_WAIT_L(0); PG8_MMA(0, 0, At, B0); PG8_BAR; PG8_SCHED;
            PG8_LDB(B1, 1, 1); PG8_STAGE(PG8_SB(1, 0), b3, voffB);
            PG8_BAR; PG8_WAIT_L(0); PG8_MMA(0, 1, At, B1); PG8_BAR;
            PG8_LDA(At, 1, 1); PG8_STAGE(PG8_SA(1, 0), a3, voffA);
            PG8_BAR; PG8_WAIT_L(0); PG8_MMA(1, 0, At, B0); PG8_BAR; PG8_SCHED;
            PG8_STAGE(PG8_SB(1, 1), b3 + hstep, voffB);
            PG8_WAIT_V(6); PG8_BAR; PG8_MMA(1, 1, At, B1); PG8_BAR;
            }
        }
        if constexpr (ALIGN_EPI) { if (wr == 0) PG8_BAR; }
        if constexpr (!Epi::AFTER_DRAIN) { E(acc, cur, wr, wc, fr, fq); S.done(cur); }
        if (!has_next) break;
#pragma unroll
        for (int a = 0; a < 2; ++a)
#pragma unroll
            for (int b = 0; b < 2; ++b)
#pragma unroll
                for (int m = 0; m < 4; ++m)
#pragma unroll
                    for (int n = 0; n < 2; ++n) acc[a][b][m][n] = (f32x4){0.f, 0.f, 0.f, 0.f};
        cur = nxt; cA = nA; cB = nB; ++ui;
        if constexpr (ALIGN_EPI) { if (wr == 1) PG8_BAR; }
    }
    PG8_WAIT_V(0);
    if constexpr (!ALIGN_EPI) { if (wr == 0) PG8_BAR; }
    PG8_BAR;
    if constexpr (Epi::AFTER_DRAIN) { E.fused(acc, cur, wr, wc, fr, fq, lds, wid, lane); S.done(cur); }
#undef PG8_SA
#undef PG8_SB
#undef PG8_STAGE
#undef PG8_LDA
#undef PG8_LDB
#undef PG8_MMA
#undef PG8_WAIT_V
#undef PG8_WAIT_L
#undef PG8_BAR
#undef PG8_SCHED
}
}
namespace mix {
using bf16 = unsigned short;
using bf16x8 = __attribute__((ext_vector_type(8))) short;
using s16x4  = __attribute__((ext_vector_type(4))) short;
using f32x16 = __attribute__((ext_vector_type(16))) float;
using u32x4  = __attribute__((ext_vector_type(4))) unsigned;
constexpr int NW = 8, QBLK = 32, KVBLK = 64, SEQ = 8192;
constexpr int SHM_V = KVBLK * 128 * 2, SHM_K = KVBLK * 128 * 2, MIX_LDS = 2 * SHM_V + 2 * SHM_K + NW * 64 * 4;
#define KSWZ(row, colB) ((row) * 256 + ((colB) ^ (((row) & 7) << 4)))
#define SBAR() __builtin_amdgcn_sched_barrier(0)
__device__ __forceinline__ int crow(int r, int hi) { return (r & 3) + 8 * (r >> 2) + 4 * hi; }
__device__ __forceinline__ unsigned cvtpk(float lo, float hi) { unsigned r; asm volatile("v_cvt_pk_bf16_f32 %0, %1, %2" : "=v"(r) : "v"(lo), "v"(hi)); return r; }
__device__ __forceinline__ float bf2f(unsigned short b) { return __uint_as_float((unsigned)b << 16); }
__device__ __forceinline__ unsigned short f2bf(float f) { return (unsigned short)(cvtpk(f, f) & 0xffffu); }
__device__ __forceinline__ int v_st(int k, int c) { const int kk = (k & ~0xC) | ((k & 4) << 1) | ((k & 8) >> 1); return ((kk >> 3) * 4 + (c >> 5)) * 512 + ((kk & 7) * 32 + (c & 31)) * 2; }
__device__ __forceinline__ int v_rd_base(int lane) { return ((lane & 3) << 3) | (((lane >> 2) & 3) << 6) | (((lane >> 4) & 1) << 5) | (((lane >> 5) & 1) << 8); }
constexpr int v_rd_off(int d0, int ks, int half) { return d0 * 512 + ks * 4096 + half * 2048; }
template <int OFF> __device__ __forceinline__ s16x4 tr_read(int vb) {
  s16x4 r; asm volatile("ds_read_b64_tr_b16 %0, %1 offset:%2" : "=&v"(r) : "v"(vb), "i"(OFF) : "memory"); return r;
}
template <int D0> __device__ __forceinline__ void pv_one(f32x16& od, int vb, bf16x8 pa0, bf16x8 pa1, bf16x8 pa2, bf16x8 pa3) {
  const s16x4 l0 = tr_read<v_rd_off(D0, 0, 0)>(vb), h0 = tr_read<v_rd_off(D0, 0, 1)>(vb), l1 = tr_read<v_rd_off(D0, 1, 0)>(vb), h1 = tr_read<v_rd_off(D0, 1, 1)>(vb);
  const s16x4 l2 = tr_read<v_rd_off(D0, 2, 0)>(vb), h2 = tr_read<v_rd_off(D0, 2, 1)>(vb), l3 = tr_read<v_rd_off(D0, 3, 0)>(vb), h3 = tr_read<v_rd_off(D0, 3, 1)>(vb);
  asm volatile("s_waitcnt lgkmcnt(0)" ::: "memory"); SBAR();
#define PK(L, H) (bf16x8){L[0], L[1], L[2], L[3], H[0], H[1], H[2], H[3]}
  od = __builtin_amdgcn_mfma_f32_32x32x16_bf16(pa0, PK(l0, h0), od, 0, 0, 0);
  od = __builtin_amdgcn_mfma_f32_32x32x16_bf16(pa1, PK(l1, h1), od, 0, 0, 0);
  od = __builtin_amdgcn_mfma_f32_32x32x16_bf16(pa2, PK(l2, h2), od, 0, 0, 0);
  od = __builtin_amdgcn_mfma_f32_32x32x16_bf16(pa3, PK(l3, h3), od, 0, 0, 0);
#undef PK
}
__device__ __forceinline__ void pv_d0(f32x16* o, int vb, bf16x8 pa0, bf16x8 pa1, bf16x8 pa2, bf16x8 pa3) {
  pv_one<0>(o[0], vb, pa0, pa1, pa2, pa3); pv_one<1>(o[1], vb, pa0, pa1, pa2, pa3); pv_one<2>(o[2], vb, pa0, pa1, pa2, pa3); pv_one<3>(o[3], vb, pa0, pa1, pa2, pa3);
}
template <int ND> __device__ __forceinline__ void qkt(f32x16& p0, f32x16& p1, const char* Ks, const bf16x8* qr, int r32, int hi, int dbase, const f32x16& cinit) {
  p0 = cinit; p1 = cinit;
#pragma unroll
  for (int d0 = 0; d0 < ND; ++d0) { const int cb = ((dbase + d0) * 16 + hi * 8) * 2;
    const bf16x8 b0 = *reinterpret_cast<const bf16x8*>(Ks + KSWZ(r32, cb));
    const bf16x8 b1 = *reinterpret_cast<const bf16x8*>(Ks + KSWZ(32 + r32, cb));
    p0 = __builtin_amdgcn_mfma_f32_32x32x16_bf16(b0, qr[d0], p0, 0, 0, 0);
    p1 = __builtin_amdgcn_mfma_f32_32x32x16_bf16(b1, qr[d0], p1, 0, 0, 0); }
}
__device__ __forceinline__ void packP(const f32x16& p0, const f32x16& p1, bf16x8& pa0, bf16x8& pa1, bf16x8& pa2, bf16x8& pa3) {
#define PK4(P, BASE, OUT) do { unsigned a0 = cvtpk(P[BASE + 0], P[BASE + 1]), a1 = cvtpk(P[BASE + 2], P[BASE + 3]);   \
    unsigned b0 = cvtpk(P[BASE + 4], P[BASE + 5]), b1 = cvtpk(P[BASE + 6], P[BASE + 7]);                              \
    auto r0 = __builtin_amdgcn_permlane32_swap(a0, b0, false, false); auto r1 = __builtin_amdgcn_permlane32_swap(a1, b1, false, false); \
    u32x4 w = {r0[0], r1[0], r0[1], r1[1]}; OUT = *reinterpret_cast<bf16x8*>(&w); } while (0)
  PK4(p0, 0, pa0); PK4(p0, 8, pa1); PK4(p1, 0, pa2); PK4(p1, 8, pa3);
#undef PK4
}
struct MixArgs {
  const bf16* DQ; const bf16* DK; const bf16* RQ; const bf16* RK; const bf16* PROJ; bf16* MIXED;
  const float* dnw;
  const float* rnw;
  float lam;
  float shift;
  const float* ldf; const float* ldb;
};
template <int MODE>
__device__ __forceinline__ void mixer_unit(const MixArgs& A, int b, int h, int qb, char* lds) {
  const int tid = ltid(), wid = __builtin_amdgcn_readfirstlane(tid >> 6), lane = tid & 63, r32 = lane & 31, hi = lane >> 5;
  char* V_lds = lds; char* K_lds = lds + 2 * SHM_V;
  float* ws = (float*)(lds + 2 * SHM_V + 2 * SHM_K) + wid * 64;
  constexpr int ND = MODE == 0 ? 4 : 8;
  const int c = MODE == 0 ? (wid >> 2) : 0, wq = MODE == 0 ? (wid & 3) : wid;
  const int q0 = qb * (MODE == 0 ? 128 : 256);
  const long tok0 = (long)b * SEQ;
  const bf16* Qw; const bf16* Kh; const bf16* Vh; int LDK;
  if (MODE == 0) { Qw = A.DQ + (tok0 + q0 + wq * QBLK + r32) * 512 + h * 128 + c * 64 + hi * 8; Kh = A.DK + tok0 * 512 + h * 128; LDK = 512; Vh = A.PROJ + tok0 * 3584 + 3072 + h * 128; }
  else           { Qw = A.RQ + ((long)(b * 4 + h) * SEQ + q0 + wq * QBLK + r32) * 128 + hi * 8; Kh = A.RK + (long)(b * 4 + h) * SEQ * 128; LDK = 128; Vh = A.PROJ + tok0 * 3584 + 1024 + h * 128; }
  constexpr int LDV = 3584;
  bf16x8 qr[ND];
#pragma unroll
  for (int d0 = 0; d0 < ND; ++d0) qr[d0] = *reinterpret_cast<const bf16x8*>(Qw + d0 * 16);
  const int sr = tid >> 4, sc = (tid & 15) * 8, vst0 = v_st(sr, sc), vst1 = v_st(32 + sr, sc);
  const int vb0 = (int)(uintptr_t)V_lds + v_rd_base(lane);
  bf16x8 vs0, vs1, ks0, ks1;
#define SLOAD(k0) do { vs0 = *reinterpret_cast<const bf16x8*>(&Vh[(long)((k0) + sr) * LDV + sc]); vs1 = *reinterpret_cast<const bf16x8*>(&Vh[(long)((k0) + 32 + sr) * LDV + sc]); \
    ks0 = *reinterpret_cast<const bf16x8*>(&Kh[(long)((k0) + sr) * LDK + sc]); ks1 = *reinterpret_cast<const bf16x8*>(&Kh[(long)((k0) + 32 + sr) * LDK + sc]); } while (0)
#define SWRITE(bb) do { *(bf16x8*)(V_lds + (bb) * SHM_V + vst0) = vs0; *(bf16x8*)(V_lds + (bb) * SHM_V + vst1) = vs1; const int kc = sc * 2; \
    *(bf16x8*)(K_lds + (bb) * SHM_K + KSWZ(sr, kc)) = ks0; *(bf16x8*)(K_lds + (bb) * SHM_K + KSWZ(32 + sr, kc)) = ks1; } while (0)
  f32x16 o[4] = {};
  float l = 0.f;
  constexpr int NT = SEQ / KVBLK;
  f32x16 cinit;
#pragma unroll
  for (int r = 0; r < 16; ++r) cinit[r] = MODE == 0 ? -A.shift : 0.f;
  if (MODE == 0) asm volatile("" : "+v"(cinit));
  const int nq = q0 + wq * QBLK + r32;
  float ldf = 0.f, nldb = 0.f;
  if (MODE == 1) { ldf = A.ldf[h] * 1.4426950408889634f; nldb = -A.ldb[h] * 1.4426950408889634f; }
  SLOAD(0); asm volatile("s_waitcnt vmcnt(0)" ::: "memory"); SWRITE(0); __syncthreads();
  for (int j = 0; j < NT; ++j) {
    const int buf = j & 1;
    if (j + 1 < NT) SLOAD((j + 1) * KVBLK);
    const char* Ks = K_lds + buf * SHM_K; const int vb = vb0 + buf * SHM_V;
    f32x16 p0, p1; bf16x8 pa0, pa1, pa2, pa3;
    qkt<ND>(p0, p1, Ks, qr, r32, hi, c * 4, cinit);
    if (MODE == 0) {
      float ps = 0.f;
#pragma unroll
      for (int r = 0; r < 16; ++r) { float a = p0[r], e = p1[r]; a = __builtin_amdgcn_exp2f(a); e = __builtin_amdgcn_exp2f(e); p0[r] = a; p1[r] = e; ps += a + e; }
      l += ps;
    } else {
      const float dbase = (float)(nq - j * KVBLK - 4 * hi);
#pragma unroll
      for (int r = 0; r < 16; ++r) { const float d = dbase - (float)((r & 3) + 8 * (r >> 2)), d2 = d - 32.0f;
        p0[r] *= __builtin_amdgcn_exp2f(d * (d >= 0.f ? ldf : nldb));
        p1[r] *= __builtin_amdgcn_exp2f(d2 * (d2 >= 0.f ? ldf : nldb)); }
    }
    packP(p0, p1, pa0, pa1, pa2, pa3);
    pv_d0(o, vb, pa0, pa1, pa2, pa3);
    if (j + 1 < NT) { asm volatile("s_waitcnt vmcnt(0)" ::: "memory"); SWRITE(buf ^ 1); }
    __syncthreads();
  }
#undef SLOAD
#undef SWRITE
  const long trow0 = tok0 + q0 + wq * QBLK;
  if (MODE == 0) {
    { auto rr = __builtin_amdgcn_permlane32_swap(__float_as_uint(l), __float_as_uint(l), false, false); l = __uint_as_float(rr[0]) + __uint_as_float(rr[1]); }
    if (hi == 0) ws[r32] = (c == 0 ? 1.0f : A.lam) / l;
    asm volatile("s_waitcnt lgkmcnt(0)" ::: "memory");
    float* xb = (float*)lds + (wq * QBLK) * 128;
    if (c == 1) {
#pragma unroll
      for (int r = 0; r < 16; ++r) { const int orow = crow(r, hi); const float a1 = ws[orow];
#pragma unroll
        for (int d0 = 0; d0 < 4; ++d0) xb[orow * 128 + d0 * 32 + r32] = o[d0][r] * a1; }
    }
    __syncthreads();
    if (c == 0) {
#pragma unroll
      for (int r = 0; r < 16; ++r) { const int orow = crow(r, hi); const float a0 = ws[orow];
        float v[4]; float ss = 0.f;
#pragma unroll
        for (int d0 = 0; d0 < 4; ++d0) { v[d0] = o[d0][r] * a0 - xb[orow * 128 + d0 * 32 + r32]; ss += v[d0] * v[d0]; }
        ss += __shfl_xor(ss, 1); ss += __shfl_xor(ss, 2); ss += __shfl_xor(ss, 4); ss += __shfl_xor(ss, 8); ss += __shfl_xor(ss, 16);
        const float rstd = 0.8f * rsqrtf(ss * (1.0f / 128.0f) + 1e-6f);
        bf16* orp = A.MIXED + (trow0 + orow) * 1024 + 512 + h * 128;
#pragma unroll
        for (int d0 = 0; d0 < 4; ++d0) orp[d0 * 32 + r32] = f2bf(v[d0] * rstd * A.dnw[d0 * 32 + r32]); }
    }
  } else {
#pragma unroll
    for (int r = 0; r < 16; ++r) { const int orow = crow(r, hi);
      float v[4]; float ss = 0.f;
#pragma unroll
      for (int d0 = 0; d0 < 4; ++d0) { v[d0] = o[d0][r]; ss += v[d0] * v[d0]; }
      ss += __shfl_xor(ss, 1); ss += __shfl_xor(ss, 2); ss += __shfl_xor(ss, 4); ss += __shfl_xor(ss, 8); ss += __shfl_xor(ss, 16);
      const float rstd = rsqrtf(ss * (1.0f / 128.0f) + 1e-6f);
      bf16* orp = A.MIXED + (trow0 + orow) * 1024 + h * 128;
      const bf16* grp = A.PROJ + (trow0 + orow) * 3584 + 1536 + h * 128;
#pragma unroll
      for (int d0 = 0; d0 < 4; ++d0) { const float g = bf2f(grp[d0 * 32 + r32]); const float sg = g / (1.0f + __expf(-g));
        orp[d0 * 32 + r32] = f2bf(v[d0] * rstd * A.rnw[h * 128 + d0 * 32 + r32] * sg); } }
  }
  __syncthreads();
}
#undef SBAR
}
constexpr int NWAVES = 8;
constexpr int BATCH = 2, SEQ = 8192, DM = 1024, T = BATCH * SEQ, NPROJ = 3584, NEXP = 32, TOPK = 4, DFF = 1024;
constexpr float EPS = 1e-6f;
constexpr int MAXROWS = 73728;
constexpr int MAXTILES = MAXROWS / 256;
constexpr size_t MiB = 1u << 20;
constexpr size_t WS_CTL = 0, CTL_ZERO_BYTES = 1 * MiB;
constexpr size_t WS_WIN = 2 * MiB;
constexpr size_t WS_WOUT = 10 * MiB;
constexpr size_t WS_W1 = 16 * MiB;
constexpr size_t WS_W2 = 144 * MiB;
constexpr size_t WS_XN = 208 * MiB;
constexpr size_t WS_PROJ = 240 * MiB;
constexpr size_t WS_RQ = 352 * MiB, WS_RK = 368 * MiB, WS_DQ = 384 * MiB, WS_DK = 400 * MiB;
constexpr size_t WS_MIXED = 416 * MiB;
constexpr size_t WS_H2 = 448 * MiB;
constexpr size_t WS_SEL = 480 * MiB;
constexpr size_t WS_SLOT = WS_SEL + 256 * 1024;
constexpr size_t WS_GATE = WS_SLOT + 256 * 1024;
constexpr size_t WS_ROWS = WS_GATE + 256 * 1024;
constexpr size_t WS_GATEP = WS_ROWS + 256 * 1024;
constexpr size_t WS_XG = 482 * MiB;
constexpr size_t WS_ACT = WS_PROJ;
constexpr size_t WS_END = 626 * MiB;
static_assert(WS_GATEP + MAXROWS * 4 <= WS_XG && WS_ACT + (size_t)MAXROWS * 2048 <= WS_DQ && WS_XG + (size_t)MAXROWS * 2048 <= WS_END, "d_ws map");
constexpr int CW_CNT = 64;
constexpr int CW_BAR = 4096;
constexpr int RING_OFF = 0, RING_BYTES = 131072;
constexpr int LDS_BYTES = 155648;
constexpr int MISC_OFF = 151552;
constexpr int TAB_OFF = 152064;
static_assert(TAB_OFF + 34 * 4 + MAXTILES <= LDS_BYTES, "LDS map");

#define GAS __attribute__((address_space(1)))
#define LAS __attribute__((address_space(3)))
typedef unsigned short bf16;
typedef unsigned v4u __attribute__((ext_vector_type(4)));
typedef unsigned v2u __attribute__((ext_vector_type(2)));
typedef float f32x4 __attribute__((ext_vector_type(4)));
typedef float f32x2 __attribute__((ext_vector_type(2)));
typedef short bf16x8 __attribute__((ext_vector_type(8)));
typedef GAS unsigned gu32;
#define RLX_AGENT __ATOMIC_RELAXED, __HIP_MEMORY_SCOPE_AGENT
#define LDS_WAIT() asm volatile("s_waitcnt lgkmcnt(0)" ::: "memory")
#define VM_WAIT() asm volatile("s_waitcnt vmcnt(0)" ::: "memory")
__device__ __forceinline__ unsigned pk2(float lo, float hi) { unsigned r; asm volatile("v_cvt_pk_bf16_f32 %0, %1, %2" : "=v"(r) : "v"(lo), "v"(hi)); return r; }
__device__ __forceinline__ float bflo(unsigned w) { return __uint_as_float(w << 16); }
__device__ __forceinline__ float bfhi(unsigned w) { return __uint_as_float(w & 0xffff0000u); }
__device__ __forceinline__ float wave_sum(float v) {
#pragma unroll
    for (int o = 1; o < 64; o <<= 1) v += __shfl_xor(v, o);
    return v;
}
__device__ __forceinline__ float wave_max(float v) {
#pragma unroll
    for (int o = 1; o < 64; o <<= 1) v = fmaxf(v, __shfl_xor(v, o));
    return v;
}
#define XB_TMO      128
#define XB_XCNT(j)  (256  + 64 * (j))
#define XB_XSUB(j)  (1280 + 64 * (j))
#define XB_XGEN(j)  (2304 + 64 * (j))
#define XB_TOP      3328
#define XB_TOPGEN   3392
#define XCD_BAR_WORDS 3456
#define XB_SPIN_CAP (1u << 18)

__device__ __forceinline__ unsigned xb_ld(unsigned* p)              { return __hip_atomic_load(p, __ATOMIC_RELAXED, __HIP_MEMORY_SCOPE_AGENT); }
__device__ __forceinline__ unsigned xb_add(unsigned* p, unsigned v) { return __hip_atomic_fetch_add(p, v, __ATOMIC_RELAXED, __HIP_MEMORY_SCOPE_AGENT); }
__device__ __forceinline__ unsigned xb_xcc_id() { return (unsigned)__builtin_amdgcn_s_getreg((3 << 11) | 20) & 0xFu; }
#define XB_SPIN(cond, bar) do { unsigned _sp = 0; while (cond) { __builtin_amdgcn_s_sleep(1); \
    if ((++_sp & 255u) == 0u) { if (xb_ld(&(bar)[XB_TMO])) break; if (_sp > XB_SPIN_CAP) { atomicAdd(&(bar)[XB_TMO], 1u); break; } } } } while (0)

struct XcdBarrier {
    unsigned* bar; unsigned x;
    volatile LAS unsigned* st;
};

__device__ __forceinline__ XcdBarrier xcd_barrier_post(unsigned* bar, volatile LAS unsigned* st) {
    XcdBarrier b; b.bar = bar; b.x = xb_xcc_id(); b.st = st;
    if (threadIdx.x == 0) (void)xb_add(&bar[XB_XCNT(b.x)], 1u);
    return b;
}
__device__ __forceinline__ void xcd_barrier_complete(unsigned* bar, unsigned x, unsigned& nloc, unsigned& nx) {
    const unsigned G = gridDim.x * gridDim.y * gridDim.z;
    unsigned sum, cnt, mine, sp = 0u;
    for (;;) {
        sum = 0u; cnt = 0u; mine = 0u;
#pragma unroll
        for (unsigned j = 0; j < 16; ++j) { const unsigned c = xb_ld(&bar[XB_XCNT(j)]); sum += c; cnt += (c > 0u) ? 1u : 0u; mine = (j == x) ? c : mine; }
        if (sum == G) break;
        __builtin_amdgcn_s_sleep(1);
        if ((++sp & 255u) == 0u) { if (xb_ld(&bar[XB_TMO])) break; if (sp > XB_SPIN_CAP) { atomicAdd(&bar[XB_TMO], 1u); break; } }
    }
    nloc = mine > 0u ? mine : 1u; nx = cnt > 0u ? cnt : 1u;
}

__device__ __forceinline__ void xcd_barrier(const XcdBarrier& b) {
    asm volatile("s_waitcnt vmcnt(0)" ::: "memory");
    __syncthreads();
    if (threadIdx.x == 0) {
        unsigned* bar = b.bar;
        __builtin_amdgcn_s_waitcnt(0);
        unsigned nloc = b.st[0], nx = b.st[1];
        if (nloc == 0u) { xcd_barrier_complete(bar, b.x, nloc, nx); b.st[0] = nloc; b.st[1] = nx; }
        const unsigned old = xb_add(&bar[XB_XSUB(b.x)], 1u);
        const unsigned gen = old / nloc;
        if (old + 1u == (gen + 1u) * nloc) {
            __builtin_amdgcn_fence(__ATOMIC_RELEASE, "agent");
            asm volatile("s_waitcnt vmcnt(0)" ::: "memory");
            const unsigned og = xb_add(&bar[XB_TOP], 1u);
            const unsigned tg = og / nx;
            if (og + 1u == (tg + 1u) * nx) xb_add(&bar[XB_TOPGEN], 1u);
            else XB_SPIN(xb_ld(&bar[XB_TOPGEN]) == tg, bar);
            __builtin_amdgcn_fence(__ATOMIC_ACQUIRE, "agent");
            xb_add(&bar[XB_XGEN(b.x)], 1u);
            asm volatile("s_waitcnt vmcnt(0)" ::: "memory");
        } else {
            XB_SPIN(xb_ld(&bar[XB_XGEN(b.x)]) == gen, bar);
            __builtin_amdgcn_fence(__ATOMIC_ACQUIRE, "agent");
            asm volatile("s_waitcnt vmcnt(0)" ::: "memory");
        }
    }
    __syncthreads();
}
struct Ctx {
    LAS unsigned char* lds; unsigned char* ws; gu32* ctl; const void* const* in; float* out;
    int tid, lane, wave, vcu, G, gw, NGW;
};
__device__ __forceinline__ void tr_item(const float* W, int K, int N, bf16* WT, int kb, int nb, int orow0, LAS float* scr, int lane) {
    const int k0 = 64 * kb, n0 = 32 * nb;
#pragma unroll 8
    for (int i = 0; i < 32; ++i) { const int kk = 2 * i + (lane >> 5); scr[kk * 33 + (lane & 31)] = W[(size_t)(k0 + kk) * N + n0 + (lane & 31)]; }
    LDS_WAIT(); asm volatile("" ::: "memory");
    const int c = lane & 7;
#pragma unroll
    for (int j = 0; j < 4; ++j) { const int n = (lane >> 3) + 8 * j; const LAS float* s = scr + (8 * c) * 33 + n;
        v4u o; o.x = pk2(s[0 * 33], s[1 * 33]); o.y = pk2(s[2 * 33], s[3 * 33]); o.z = pk2(s[4 * 33], s[5 * 33]); o.w = pk2(s[6 * 33], s[7 * 33]);
        *(GAS v4u*)(WT + (size_t)(orow0 + n) * K + k0 + 8 * c) = o; }
    LDS_WAIT(); asm volatile("" ::: "memory");
}
__device__ __forceinline__ void phase_prologue(const Ctx& C) {
    LAS float* scr = (LAS float*)(C.lds + C.wave * 16384);
    const float* w_in = (const float*)C.in[3]; const float* w_out = (const float*)C.in[14]; const float* w1 = (const float*)C.in[18]; const float* w2 = (const float*)C.in[20];
    bf16* WIN = (bf16*)(C.ws + WS_WIN); bf16* WOUT = (bf16*)(C.ws + WS_WOUT); bf16* W1T = (bf16*)(C.ws + WS_W1); bf16* W2T = (bf16*)(C.ws + WS_W2);
    constexpr int I_IN = 16 * 112, I_OUT = 16 * 32, I_W1 = 32 * 16 * 64, I_W2 = 32 * 16 * 32, NITEMS = I_IN + I_OUT + I_W1 + I_W2;
    for (int it = C.gw; it < NITEMS; it += C.NGW) {
        int r = it;
        if (r < I_IN) { tr_item(w_in, 1024, NPROJ, WIN, r / 112, r % 112, 32 * (r % 112), scr, C.lane); continue; } r -= I_IN;
        if (r < I_OUT) { tr_item(w_out, 1024, 1024, WOUT, r / 32, r % 32, 32 * (r % 32), scr, C.lane); continue; } r -= I_OUT;
        if (r < I_W1) { const int e = r >> 10, rr = r & 1023, kb = rr >> 6, nb = rr & 63, n0 = 32 * nb;
            const int orow0 = (n0 < 1024) ? 256 * (n0 >> 7) + (n0 & 127) : 256 * ((n0 - 1024) >> 7) + 128 + ((n0 - 1024) & 127);
            tr_item(w1 + (size_t)e * 1024 * 2048, 1024, 2048, W1T + (size_t)e * 2048 * 1024, kb, nb, orow0, scr, C.lane); continue; } r -= I_W1;
        { const int e = r >> 9, rr = r & 511, kb = rr >> 5, nb = rr & 31;
            tr_item(w2 + (size_t)e * 1024 * 1024, 1024, 1024, W2T + (size_t)e * 1024 * 1024, kb, nb, 32 * nb, scr, C.lane); }
    }
    const float* x = (const float*)C.in[0]; const float* n1w = (const float*)C.in[2]; bf16* XN = (bf16*)(C.ws + WS_XN);
    f32x4 wv[4];
#pragma unroll
    for (int j = 0; j < 4; ++j) wv[j] = ((const GAS f32x4*)n1w)[C.lane + 64 * j];
    for (int m = C.gw; m < T; m += C.NGW) {
        const GAS f32x4* xr = (const GAS f32x4*)(x + (size_t)m * DM) + C.lane;
        f32x4 v[4]; float s = 0.f;
#pragma unroll
        for (int j = 0; j < 4; ++j) { v[j] = xr[64 * j]; s += (v[j].x * v[j].x + v[j].y * v[j].y) + (v[j].z * v[j].z + v[j].w * v[j].w); }
        const float rstd = rsqrtf(wave_sum(s) * (1.f / DM) + EPS);
        GAS v2u* o8 = (GAS v2u*)(XN + (size_t)m * DM) + C.lane;
#pragma unroll
        for (int j = 0; j < 4; ++j) { const f32x4 y = v[j] * rstd * wv[j]; v2u o; o.x = pk2(y.x, y.y); o.y = pk2(y.z, y.w); o8[64 * j] = o; }
    }
}
__device__ __forceinline__ double dexp_small(double y) {
    const double z = y * (1.0 / 1024.0);
    double r = 1.0 + z * (1.0 + z * (0.5 + z * (1.0 / 6.0 + z * (1.0 / 24.0 + z * (1.0 / 120.0 + z * (1.0 / 720.0))))));
#pragma unroll
    for (int i = 0; i < 10; ++i) r *= r;
    return r;
}
__device__ __forceinline__ void unpack8(const v4u w, float (&f)[8]) {
#pragma unroll
    for (int j = 0; j < 4; ++j) { f[2 * j] = bflo(w[j]); f[2 * j + 1] = bfhi(w[j]); }
}
__device__ __forceinline__ v4u pack8(const float (&f)[8]) { v4u w; w.x = pk2(f[0], f[1]); w.y = pk2(f[2], f[3]); w.z = pk2(f[4], f[5]); w.w = pk2(f[6], f[7]); return w; }
constexpr float QSCALE = 0.125f * 1.4426950408889634f;
__device__ __forceinline__ void phase_qk(const Ctx& C) {
    LAS double* revt = (LAS double*)(C.lds);
    if (C.tid < 72) { const double y = C.tid < 64 ? -((double)C.tid / 63.0) * 9.210340371976184 : -((double)(C.tid - 64) / 8.0) * 13.122363377404328;
        revt[C.tid] = dexp_small(y) * 0.15915494309189535; }
    __syncthreads();
    const int* positions = (const int*)C.in[1]; const float* qnw = (const float*)C.in[7]; const float* knw = (const float*)C.in[8];
    const bf16* PROJ = (const bf16*)(C.ws + WS_PROJ);
    bf16* RQ = (bf16*)(C.ws + WS_RQ); bf16* RK = (bf16*)(C.ws + WS_RK); bf16* DQ = (bf16*)(C.ws + WS_DQ); bf16* DK = (bf16*)(C.ws + WS_DK);
    const int L = C.lane;
    float qw[8], kw[8];
#pragma unroll
    for (int e = 0; e < 8; ++e) { qw[e] = qnw[(L & 7) * 8 + e]; kw[e] = knw[(L & 7) * 8 + e]; }
    for (int t = C.gw; t < T; t += C.NGW) {
        const int b = t / SEQ, s = t % SEQ; const double pos = (double)positions[t];
        const bf16* prow = PROJ + (size_t)t * NPROJ;
        {
            float qf[8], kf[8], qo[8], ko[8];
            unpack8(*(const GAS v4u*)(prow + 8 * L), qf); unpack8(*(const GAS v4u*)(prow + 512 + 8 * L), kf);
            const int head = L >> 4, half = (L >> 3) & 1, i0 = (L & 7) * 8;
#pragma unroll
            for (int e = 0; e < 8; ++e) { double a = pos * revt[i0 + e]; a -= rint(a); const float fr = (float)a;
                const float c = __builtin_amdgcn_cosf(fr), sn = __builtin_amdgcn_sinf(fr);
                const float qp = __shfl_xor(qf[e], 8), kp = __shfl_xor(kf[e], 8);
                qo[e] = half ? qf[e] * c + qp * sn : qf[e] * c - qp * sn;
                ko[e] = (half ? kf[e] * c + kp * sn : kf[e] * c - kp * sn) * 0.08838834764831845f; }
            const size_t o = ((size_t)(b * 4 + head) * SEQ + s) * 128 + (L & 15) * 8;
            *(GAS v4u*)(RQ + o) = pack8(qo); *(GAS v4u*)(RK + o) = pack8(ko);
        }
        {
            float qf[8], kf[8];
            unpack8(*(const GAS v4u*)(prow + 2048 + 8 * L), qf); unpack8(*(const GAS v4u*)(prow + 2560 + 8 * L), kf);
            float sq = 0.f, sk = 0.f;
#pragma unroll
            for (int e = 0; e < 8; ++e) { sq += qf[e] * qf[e]; sk += kf[e] * kf[e]; }
            sq += __shfl_xor(sq, 1); sq += __shfl_xor(sq, 2); sq += __shfl_xor(sq, 4);
            sk += __shfl_xor(sk, 1); sk += __shfl_xor(sk, 2); sk += __shfl_xor(sk, 4);
            const float rq = rsqrtf(sq * (1.f / 64.f) + EPS), rk = rsqrtf(sk * (1.f / 64.f) + EPS);
            const int sel = L & 7;
#pragma unroll
            for (int e = 0; e < 8; ++e) { float y = qf[e] * rq * qw[e], z = kf[e] * rk * kw[e];
                double a = pos * revt[64 + e]; a -= rint(a); const float fr = (float)a;
                const float c = __builtin_amdgcn_cosf(fr), sn = __builtin_amdgcn_sinf(fr);
                const float yp = __shfl_xor(y, 1), zp = __shfl_xor(z, 1);
                if (sel == 0) { y = y * c - yp * sn; z = z * c - zp * sn; }
                else if (sel == 1) { y = y * c + yp * sn; z = z * c + zp * sn; }
                qf[e] = y * QSCALE; kf[e] = z; }
            *(GAS v4u*)(DQ + (size_t)t * 512 + 8 * L) = pack8(qf); *(GAS v4u*)(DK + (size_t)t * 512 + 8 * L) = pack8(kf);
        }
    }
}
__device__ __forceinline__ void phase_mix(const Ctx& C, unsigned char* lds_generic) {
    const float* qnw = (const float*)C.in[7]; const float* knw = (const float*)C.in[8];
    const float s1 = wave_sum(((const float*)C.in[9])[C.lane] * ((const float*)C.in[10])[C.lane]);
    const float s2 = wave_sum(((const float*)C.in[11])[C.lane] * ((const float*)C.in[12])[C.lane]);
    const float mq = wave_max(fabsf(qnw[C.lane])), mk = wave_max(fabsf(knw[C.lane]));
    const float bound = 8.0f * 1.4426950408889634f * mq * mk * 1.001f;
    mix::MixArgs A;
    A.DQ = (const bf16*)(C.ws + WS_DQ); A.DK = (const bf16*)(C.ws + WS_DK); A.RQ = (const bf16*)(C.ws + WS_RQ); A.RK = (const bf16*)(C.ws + WS_RK);
    A.PROJ = (const bf16*)(C.ws + WS_PROJ); A.MIXED = (bf16*)(C.ws + WS_MIXED);
    A.dnw = (const float*)C.in[13]; A.rnw = (const float*)C.in[6];
    A.lam = __int_as_float(__builtin_amdgcn_readfirstlane(__float_as_int(__expf(s1) - __expf(s2) + 0.2f)));
    A.shift = __int_as_float(__builtin_amdgcn_readfirstlane(__float_as_int(bound)));
    A.ldf = (const float*)C.in[4]; A.ldb = (const float*)C.in[5];
    for (int u = C.vcu; u < 512; u += C.G) { const int b = u >> 8, h = (u >> 6) & 3, qb = u & 63; mix::mixer_unit<0>(A, b, h, qb, (char*)lds_generic); }
    for (int u = C.vcu; u < 256; u += C.G) { const int b = u >> 7, h = (u >> 5) & 3, qb = u & 31; mix::mixer_unit<1>(A, b, h, qb, (char*)lds_generic); }
}
__device__ __forceinline__ void phase_route(const Ctx& C) {
    const float* wr = (const float*)C.in[16]; const float* br = (const float*)C.in[17]; const float* n2w = (const float*)C.in[15];
    LAS float* wl = (LAS float*)C.lds;
    for (int i = C.tid; i < 1024 * 8; i += NWAVES * 64) { const int row = i >> 3, q = i & 7; *(LAS f32x4*)(wl + row * 36 + 4 * q) = ((const GAS f32x4*)wr)[i]; }
    __syncthreads();
    bf16* H2 = (bf16*)(C.ws + WS_H2); int* SEL = (int*)(C.ws + WS_SEL); int* SLOT = (int*)(C.ws + WS_SLOT); float* GATE = (float*)(C.ws + WS_GATE);
    float nw[16];
#pragma unroll
    for (int j = 0; j < 16; ++j) nw[j] = n2w[C.lane + 64 * j];
    for (int t = C.gw; t < T; t += C.NGW) {
        const float* xr = C.out + (size_t)t * DM;
        float xv[16]; float ss = 0.f;
#pragma unroll
        for (int j = 0; j < 16; ++j) { xv[j] = xr[C.lane + 64 * j]; ss += xv[j] * xv[j]; }
        const float rstd = rsqrtf(wave_sum(ss) * (1.f / DM) + EPS);
        float lg[32];
#pragma unroll
        for (int e = 0; e < 32; ++e) lg[e] = 0.f;
        bf16* hrow = H2 + (size_t)t * DM;
#pragma unroll
        for (int j = 0; j < 16; ++j) { const float h = xv[j] * rstd * nw[j]; hrow[C.lane + 64 * j] = (bf16)(pk2(h, h) & 0xffffu);
            const LAS f32x4* wp = (const LAS f32x4*)(wl + (C.lane + 64 * j) * 36);
#pragma unroll
            for (int q = 0; q < 8; ++q) { const f32x4 w4 = wp[q]; lg[4 * q] += h * w4.x; lg[4 * q + 1] += h * w4.y; lg[4 * q + 2] += h * w4.z; lg[4 * q + 3] += h * w4.w; } }
#pragma unroll
        for (int e = 0; e < 32; ++e) lg[e] = wave_sum(lg[e]) + br[e];
        int idx[4]; float val[4];
#pragma unroll
        for (int k = 0; k < 4; ++k) { float best = -INFINITY; int bi = 0;
#pragma unroll
            for (int e = 0; e < 32; ++e) { if (lg[e] > best) { best = lg[e]; bi = e; } }
#pragma unroll
            for (int e = 0; e < 32; ++e) lg[e] = (e == bi) ? -INFINITY : lg[e];
            idx[k] = bi; val[k] = best; }
        float ex[4], es = 0.f;
#pragma unroll
        for (int k = 0; k < 4; ++k) { ex[k] = __expf(val[k] - val[0]); es += ex[k]; }
        const float ri = 1.0f / es;
        if (C.lane == 0) {
#pragma unroll
            for (int k = 0; k < 4; ++k) { const unsigned sl = __hip_atomic_fetch_add((unsigned*)(C.ctl + CW_CNT + idx[k]), 1u, __ATOMIC_RELAXED, __HIP_MEMORY_SCOPE_AGENT);
                SEL[t * 4 + k] = idx[k]; SLOT[t * 4 + k] = (int)sl; GATE[t * 4 + k] = ex[k] * ri; } }
    }
}
__device__ __forceinline__ void moe_tables(const Ctx& C) {
    LAS int* padoff = (LAS int*)(C.lds + TAB_OFF); LAS unsigned char* tile_e = C.lds + TAB_OFF + 34 * 4;
    LAS int* cnts = (LAS int*)(C.lds + MISC_OFF + 128);
    if (C.tid < 32) cnts[C.tid] = (int)__hip_atomic_load(C.ctl + CW_CNT + C.tid, RLX_AGENT);
    __syncthreads();
    if (C.tid == 0) { int off = 0, nt = 0;
        for (int e = 0; e < 32; ++e) { const int n = (cnts[e] + 255) >> 8; padoff[e] = off; for (int k = 0; k < n; ++k) tile_e[nt++] = (unsigned char)e; off += n * 256; }
        padoff[32] = off; padoff[33] = nt; }
    __syncthreads();
}
__device__ __forceinline__ void phase_scatter(const Ctx& C) {
    moe_tables(C);
    const LAS int* padoff = (const LAS int*)(C.lds + TAB_OFF);
    const bf16* H2 = (const bf16*)(C.ws + WS_H2); bf16* XG = (bf16*)(C.ws + WS_XG);
    const int* SEL = (const int*)(C.ws + WS_SEL); const int* SLOT = (const int*)(C.ws + WS_SLOT); const float* GATE = (const float*)(C.ws + WS_GATE);
    int* ROWS = (int*)(C.ws + WS_ROWS); float* GATEP = (float*)(C.ws + WS_GATEP);
    for (int t = C.gw; t < T; t += C.NGW) {
        const GAS v4u* hr = (const GAS v4u*)(H2 + (size_t)t * DM);
        const v4u h0 = hr[C.lane], h1 = hr[C.lane + 64];
#pragma unroll
        for (int k = 0; k < 4; ++k) { const int e = SEL[t * 4 + k], sl = SLOT[t * 4 + k]; const int row = padoff[e] + sl;
            GAS v4u* xr = (GAS v4u*)(XG + (size_t)row * DM); xr[C.lane] = h0; xr[C.lane + 64] = h1;
            if (C.lane == 0) { ROWS[t * 4 + k] = row; GATEP[row] = GATE[t * 4 + k]; } }
    }
}
__device__ __forceinline__ void phase_combine(const Ctx& C) {
    const bf16* YB = (const bf16*)(C.ws + WS_XG); const int* ROWS = (const int*)(C.ws + WS_ROWS);
    for (int t = C.gw; t < T; t += C.NGW) {
        int rw[4];
#pragma unroll
        for (int k = 0; k < 4; ++k) rw[k] = ROWS[t * 4 + k];
        GAS f32x4* orow = (GAS f32x4*)(C.out + (size_t)t * DM) + C.lane;
#pragma unroll
        for (int j = 0; j < 4; ++j) { f32x4 v = orow[64 * j];
#pragma unroll
            for (int k = 0; k < 4; ++k) { const v2u y = ((const GAS v2u*)(YB + (size_t)rw[k] * DM))[C.lane + 64 * j];
                v.x += bflo(y.x); v.y += bfhi(y.x); v.z += bflo(y.y); v.w += bfhi(y.y); }
            orow[64 * j] = v; }
    }
}
constexpr int N_PHASES = 10;
struct Args { const void* in[22]; float* out; unsigned char* ws; };
template <int LO, int HI>
__global__ void __launch_bounds__(NWAVES * 64, 2) mk_fwd(Args args) {
    extern __shared__ __attribute__((aligned(16))) unsigned char lds[];
    Ctx C;
    C.lds = (LAS unsigned char*)lds; C.ws = args.ws; C.ctl = (gu32*)(args.ws + WS_CTL); C.in = args.in; C.out = args.out;
    C.tid = ltid(); C.lane = C.tid & 63; C.wave = __builtin_amdgcn_readfirstlane((int)threadIdx.x >> 6);
    C.G = gridDim.x; { const int bx = blockIdx.x; C.vcu = (C.G % 8 == 0) ? (bx % 8) * (C.G / 8) + bx / 8 : bx; }
    C.gw = C.vcu * NWAVES + C.wave; C.NGW = C.G * NWAVES;
    volatile LAS unsigned* MISC = (volatile LAS unsigned*)(C.lds + MISC_OFF);
    if (C.tid < 32) MISC[C.tid] = 0u;
    __syncthreads();
    XcdBarrier bar; bar.bar = (unsigned*)(C.ctl + CW_BAR); bar.x = 0; bar.st = nullptr;
    if (HI - LO > 1) bar = xcd_barrier_post((unsigned*)(C.ctl + CW_BAR), MISC + 8);
#define GRID_BAR() xcd_barrier(bar)
#ifdef PH_ONLY
#define IN(k) ((k) == PH_ONLY && LO <= (k) && (k) < HI)
#else
#define IN(k) (LO <= (k) && (k) < HI)
#endif
#define SEAM(k) do { if (IN(k) && IN((k) + 1)) GRID_BAR(); C.tid = ltid(); C.lane = C.tid & 63; } while (0)
    if (IN(0)) { phase_prologue(C); SEAM(0); }
    if (IN(1)) {
        pg8::Gemm g{(const bf16*)(C.ws + WS_XN), (const bf16*)(C.ws + WS_WIN), T, NPROJ, DM}; pg8::StaticOrder S; S.init(T, NPROJ, C.G, (int)blockIdx.x);
        pg8::EpiStoreBf16 E{(bf16*)(C.ws + WS_PROJ), NPROJ};
        pg8::gemm_phase<pg8::EpiStoreBf16, pg8::StaticOrder, true, true>(C.lds + RING_OFF, g, S, E);
        SEAM(1);
    }
    if (IN(2)) { phase_qk(C); SEAM(2); }
    if (IN(3)) { phase_mix(C, lds); SEAM(3); }
    if (IN(4)) {
        pg8::Gemm g{(const bf16*)(C.ws + WS_MIXED), (const bf16*)(C.ws + WS_WOUT), T, DM, DM}; pg8::StaticOrder S; S.init(T, DM, C.G, (int)blockIdx.x);
        pg8::EpiResF32 E{(const float*)C.in[0], C.out, DM};
        pg8::gemm_phase<pg8::EpiResF32, pg8::StaticOrder, true, true>(C.lds + RING_OFF, g, S, E);
        SEAM(4);
    }
    if (IN(5)) { phase_route(C); SEAM(5); }
    if (IN(6)) { phase_scatter(C); SEAM(6); }
    if (IN(7)) {
        moe_tables(C);
        const LAS int* padoff = (const LAS int*)(C.lds + TAB_OFF);
        pg8::Gemm g{(const bf16*)(C.ws + WS_XG), (const bf16*)(C.ws + WS_W1), MAXROWS, NEXP * 2048, DM};
        pg8::MoeOrder S{padoff[33] * 8, 8, C.G, C.vcu, (const LAS unsigned char*)(C.lds + TAB_OFF + 34 * 4)};
        pg8::EpiSwiglu E{(bf16*)(C.ws + WS_ACT), (const float*)C.in[19]};
        pg8::gemm_phase<pg8::EpiSwiglu, pg8::MoeOrder, true, true>(C.lds + RING_OFF, g, S, E);
        SEAM(7);
    }
    if (IN(8)) {
        moe_tables(C);
        const LAS int* padoff = (const LAS int*)(C.lds + TAB_OFF);
        pg8::Gemm g{(const bf16*)(C.ws + WS_ACT), (const bf16*)(C.ws + WS_W2), MAXROWS, NEXP * 1024, DFF};
        pg8::MoeOrder S{padoff[33] * 4, 4, C.G, C.vcu, (const LAS unsigned char*)(C.lds + TAB_OFF + 34 * 4)};
        pg8::EpiGateBf16 E{(bf16*)(C.ws + WS_XG), (const float*)C.in[21], (const float*)(C.ws + WS_GATEP)};
        pg8::gemm_phase<pg8::EpiGateBf16, pg8::MoeOrder, true, true>(C.lds + RING_OFF, g, S, E);
        SEAM(8);
    }
    if (IN(9)) { phase_combine(C); }
#undef IN
#undef SEAM
}

template <int LO, int HI> static void launch_range(int grid, const Args& a, hipStream_t stream) {
    static bool attr_set = false;
    if (!attr_set) { if (hipFuncSetAttribute((const void*)mk_fwd<LO, HI>, hipFuncAttributeMaxDynamicSharedMemorySize, LDS_BYTES) != hipSuccess) fprintf(stderr, "kernel_launch: hipFuncSetAttribute failed\n"); attr_set = true; }
    hipLaunchKernelGGL((mk_fwd<LO, HI>), dim3(grid), dim3(NWAVES * 64), LDS_BYTES, stream, a);
}
extern "C" void kernel_launch(void* const* d_in, const int* in_sizes, int n_in, void* d_out, int out_size, void* d_ws, size_t ws_size, hipStream_t stream) {
    static int grid = 0;
    if (grid == 0) {
        if (n_in != 22 || in_sizes[0] != T * DM || out_size != T * DM || ws_size < WS_END) {
            fprintf(stderr, "kernel_launch: shape mismatch (n_in %d, in0 %d, out %d, ws %zu; need ws >= %zu); nothing launched\n", n_in, n_in > 0 ? in_sizes[0] : -1, out_size, ws_size, (size_t)WS_END); grid = -1; return; }
        int dev = 0, cus = 0;
        if (hipGetDevice(&dev) != hipSuccess || hipDeviceGetAttribute(&cus, hipDeviceAttributeMultiprocessorCount, dev) != hipSuccess) { fprintf(stderr, "kernel_launch: device query failed\n"); grid = -1; return; }
        grid = cus;
    }
    if (grid < 0) return;
    if (hipMemsetAsync((char*)d_ws + WS_CTL, 0, CTL_ZERO_BYTES, stream) != hipSuccess) { fprintf(stderr, "kernel_launch: memset failed\n"); return; }
    Args a{};
    for (int i = 0; i < 22; ++i) a.in[i] = d_in[i];
    a.out = (float*)d_out; a.ws = (unsigned char*)d_ws;
#if MK_SPLIT
    launch_range<0, 1>(grid, a, stream); launch_range<1, 2>(grid, a, stream); launch_range<2, 3>(grid, a, stream); launch_range<3, 4>(grid, a, stream); launch_range<4, 5>(grid, a, stream);
    launch_range<5, 6>(grid, a, stream); launch_range<6, 7>(grid, a, stream); launch_range<7, 8>(grid, a, stream); launch_range<8, 9>(grid, a, stream); launch_range<9, 10>(grid, a, stream);
#else
    launch_range<0, N_PHASES>(grid, a, stream);
#endif
    const hipError_t le = hipPeekAtLastError();
    if (le != hipSuccess) fprintf(stderr, "kernel_launch: launch failed: %s\n", hipGetErrorName(le));
}
```

```cpp
#include <hip/hip_runtime.h>
#include <hip/hip_bf16.h>
#include <cstdio>
#include <cstdint>
#include <cmath>
#ifndef MK_SPLIT
#define MK_SPLIT 0
#endif
__device__ __forceinline__ int ltid() { int t = (int)threadIdx.x; asm volatile("" : "+v"(t)); return t; }
namespace pg8 {
#define PG8_LAS __attribute__((address_space(3)))
typedef unsigned short bf16_t;
typedef short bf16x8 __attribute__((ext_vector_type(8)));
typedef float f32x4 __attribute__((ext_vector_type(4)));
typedef unsigned u32x4 __attribute__((ext_vector_type(4)));
constexpr int BM = 256, BK = 64, HALF = 128, HTB = HALF * BK * 2  , STAGE_BYTES = 8 * HTB, NXCD = 8, WGM = 8;

__host__ __device__ __forceinline__ int lds_byte(int r, int c) { const int st = (r >> 4) * 2 + (c >> 5), rr = r & 15, cc = c & 31, ob = rr * 64 + cc * 2; return st * 1024 + (ob ^ (((ob >> 9) & 1) << 5)); }
__host__ __device__ __forceinline__ void stage_rc(int b, int& R, int& C) { const int st = b / 1024, sb = b % 1024, swz = sb ^ (((sb >> 9) & 1) << 5); R = (st >> 1) * 16 + swz / 64; C = (st & 1) * 32 + (swz % 64) / 2; }
__host__ __device__ __forceinline__ int perm32(int rho) { const int n = rho >> 4, i = rho & 15; return 8 * (i >> 2) + 4 * n + (i & 3); }

struct Unit { int pm, pn; };
struct Gemm { const bf16_t* A; const bf16_t* Bt; int M, N, K; };

struct StaticOrder {
    int nM, nN, nwg, G, c;
    __host__ __device__ void init(int M, int N, int G_, int c_) { nM = M / BM; nN = N / BM; nwg = nM * nN; G = G_; c = c_; }
    __host__ __device__ bool next(int i, Unit& u) const {
        const long L = (long)i * G + c; if (L >= nwg) return false;
        int wgid = (int)L; { const int q = nwg / NXCD, r = nwg % NXCD, xcd = wgid % NXCD, off = wgid / NXCD; wgid = (xcd < r ? xcd * (q + 1) : r * (q + 1) + (xcd - r) * q) + off; }
        const int nig = WGM * nN, gid = wgid / nig, fm = gid * WGM, gsz = (nM - fm) < WGM ? (nM - fm) : WGM;
        u.pm = fm + ((wgid % nig) % gsz); u.pn = (wgid % nig) / gsz; return true;
    }
    __device__ __forceinline__ void a_ready(const Unit&) const {}
    __device__ __forceinline__ void done(const Unit&) const {}
};

__device__ __forceinline__ unsigned cvt_pk_bf16(float lo, float hi) { unsigned r; asm volatile("v_cvt_pk_bf16_f32 %0, %1, %2" : "=v"(r) : "v"(lo), "v"(hi)); return r; }
typedef float f32x2 __attribute__((ext_vector_type(2)));
struct EpiStoreBf16 {
    static constexpr bool PERM = true, AFTER_DRAIN = false;
    bf16_t* O; int ldc;
    __device__ __forceinline__ void operator()(const f32x4 (&acc)[2][2][4][2], const Unit& u, int wr, int wc, int fr, int fq) const {
        const int row0 = u.pm * BM + wr * 64 + fr, col0 = u.pn * BM + wc * 32 + 8 * fq;
#pragma unroll
        for (int ai = 0; ai < 2; ++ai)
#pragma unroll
            for (int m = 0; m < 4; ++m) { bf16_t* rowp = O + (size_t)(row0 + ai * HALF + m * 16) * ldc + col0;
#pragma unroll
                for (int bj = 0; bj < 2; ++bj) { const f32x4 v0 = acc[ai][bj][m][0], v1 = acc[ai][bj][m][1];
                    u32x4 w; w.x = cvt_pk_bf16(v0[0], v0[1]); w.y = cvt_pk_bf16(v0[2], v0[3]); w.z = cvt_pk_bf16(v1[0], v1[1]); w.w = cvt_pk_bf16(v1[2], v1[3]);
                    *(u32x4*)(rowp + bj * HALF) = w; } }
    }
};
struct EpiResF32 {
    static constexpr bool PERM = false, AFTER_DRAIN = false;
    const float* base; float* out; int ldc;
    __device__ __forceinline__ void operator()(const f32x4 (&acc)[2][2][4][2], const Unit& u, int wr, int wc, int fr, int fq) const {
        const int row0 = u.pm * BM + wr * 64 + fr, col0 = u.pn * BM + wc * 32 + 4 * fq;
#pragma unroll
        for (int ai = 0; ai < 2; ++ai)
#pragma unroll
            for (int m = 0; m < 4; ++m) { const size_t off = (size_t)(row0 + ai * HALF + m * 16) * ldc + col0;
#pragma unroll
                for (int bj = 0; bj < 2; ++bj)
#pragma unroll
                    for (int n = 0; n < 2; ++n) { const f32x4 bs = *(const f32x4*)(base + off + bj * HALF + n * 16); *(f32x4*)(out + off + bj * HALF + n * 16) = bs + acc[ai][bj][m][n]; } }
    }
};
struct EpiSwiglu {
    static constexpr bool PERM = true, AFTER_DRAIN = false;
    bf16_t* ACT; const float* b1;
    __device__ __forceinline__ void operator()(const f32x4 (&acc)[2][2][4][2], const Unit& u, int wr, int wc, int fr, int fq) const {
        const int e = u.pn >> 3, pnl = u.pn & 7, colact0 = pnl * 128 + wc * 32 + 8 * fq;
        const int row0 = u.pm * BM + wr * 64 + fr;
        f32x4 bg[2], bl[2];
#pragma unroll
        for (int n = 0; n < 2; ++n) { bg[n] = *(const f32x4*)(b1 + (size_t)e * 2048 + colact0 + 4 * n); bl[n] = *(const f32x4*)(b1 + (size_t)e * 2048 + 1024 + colact0 + 4 * n); }
#pragma unroll
        for (int ai = 0; ai < 2; ++ai)
#pragma unroll
            for (int m = 0; m < 4; ++m) { float a[8];
#pragma unroll
                for (int n = 0; n < 2; ++n) { const f32x4 g4 = acc[ai][0][m][n] + bg[n], l4 = acc[ai][1][m][n] + bl[n];
#pragma unroll
                    for (int i = 0; i < 4; ++i) { const float g = fminf(g4[i], 7.0f), l = fminf(fmaxf(l4[i], -7.0f), 7.0f);
                        const float sg = __builtin_amdgcn_rcpf(1.0f + __builtin_amdgcn_exp2f(-1.702f * 1.4426950408889634f * g));
                        a[4 * n + i] = g * sg * (l + 1.0f); } }
                u32x4 w; w.x = cvt_pk_bf16(a[0], a[1]); w.y = cvt_pk_bf16(a[2], a[3]); w.z = cvt_pk_bf16(a[4], a[5]); w.w = cvt_pk_bf16(a[6], a[7]);
                *(u32x4*)(ACT + (size_t)(row0 + ai * HALF + m * 16) * 1024 + colact0) = w; }
    }
};
struct EpiGateBf16 {
    static constexpr bool PERM = true, AFTER_DRAIN = false;
    bf16_t* Y; const float* b2; const float* gatep;
    __device__ __forceinline__ void operator()(const f32x4 (&acc)[2][2][4][2], const Unit& u, int wr, int wc, int fr, int fq) const {
        const int e = u.pn >> 2, pnl = u.pn & 3, col0 = pnl * BM + wc * 32 + 8 * fq;
        const int row0 = u.pm * BM + wr * 64 + fr;
        f32x4 bv[2][2];
#pragma unroll
        for (int bj = 0; bj < 2; ++bj)
#pragma unroll
            for (int n = 0; n < 2; ++n) bv[bj][n] = *(const f32x4*)(b2 + (size_t)e * 1024 + col0 + bj * HALF + 4 * n);
#pragma unroll
        for (int ai = 0; ai < 2; ++ai)
#pragma unroll
            for (int m = 0; m < 4; ++m) { const int row = row0 + ai * HALF + m * 16; const float g = gatep[row];
#pragma unroll
                for (int bj = 0; bj < 2; ++bj) { const f32x4 v0 = (acc[ai][bj][m][0] + bv[bj][0]) * g, v1 = (acc[ai][bj][m][1] + bv[bj][1]) * g;
                    u32x4 w; w.x = cvt_pk_bf16(v0[0], v0[1]); w.y = cvt_pk_bf16(v0[2], v0[3]); w.z = cvt_pk_bf16(v1[0], v1[1]); w.w = cvt_pk_bf16(v1[2], v1[3]);
                    *(u32x4*)(Y + (size_t)row * 1024 + col0 + bj * HALF) = w; } }
    }
};
struct MoeOrder {
    int nunits, npn, G, c; const PG8_LAS unsigned char* tile_e;
    __device__ __forceinline__ bool next(int i, Unit& u) const {
        const long L = (long)i * G + c; if (L >= nunits) return false;
        const int tm = (int)L / npn, j = (int)L % npn; u.pm = tm; u.pn = (int)tile_e[tm] * npn + j; return true;
    }
    __device__ __forceinline__ void a_ready(const Unit&) const {}
    __device__ __forceinline__ void done(const Unit&) const {}
};
template <class Epi, class Sched, bool ALIGN_EPI = false, bool SP2 = false>
__device__ __forceinline__ void gemm_phase(PG8_LAS unsigned char* lds, const Gemm g, const Sched& S, const Epi& E) {
    const int tid = ltid(), wid = __builtin_amdgcn_readfirstlane(tid >> 6), lane = tid & 63, wr = wid >> 2, wc = wid & 3, fr = lane & 15, fq = lane >> 4;
    const int K = g.K, nt = K / BK;
    unsigned voffA[2], voffB[2];
#pragma unroll
    for (int i = 0; i < 2; ++i) { int R, C; stage_rc(tid * 16 + i * 8192, R, C); const int Rb = Epi::PERM ? ((R & ~31) + perm32(R & 31)) : R;
        voffA[i] = (unsigned)(R * K + C) * 2u; voffB[i] = (unsigned)(Rb * K + C) * 2u; }
    const size_t kstep = (size_t)(BK * 2);
    const size_t hstep = (size_t)HALF * K * 2;
    const size_t tstep = 2 * hstep;
    const unsigned ldsw = (unsigned)wid * 1024u;
    const int aoff = lds_byte(wr * 64 + fr, fq * 8), boff = lds_byte(wc * 32 + fr, fq * 8);
#define PG8_SA(b, h) (((b) * 2 + (h)) * HTB)
#define PG8_SB(b, h) ((4 + (b) * 2 + (h)) * HTB)
#define PG8_STAGE(bufoff, gbase, voff) do { _Pragma("unroll") for (int _i = 0; _i < 2; ++_i) \
        __builtin_amdgcn_global_load_lds((const unsigned*)((const char*)(gbase) + (voff)[_i]), (PG8_LAS unsigned*)(lds + (bufoff) + ldsw + _i * 8192), 16, 0, 0); } while (0)
#define PG8_LDA(dst, b, h) do { _Pragma("unroll") for (int m = 0; m < 4; ++m) _Pragma("unroll") for (int k = 0; k < 2; ++k) dst[m][k] = *(const PG8_LAS bf16x8*)(lds + PG8_SA(b, h) + aoff + m * 2048 + k * 1024); } while (0)
#define PG8_LDB(dst, b, h) do { _Pragma("unroll") for (int n = 0; n < 2; ++n) _Pragma("unroll") for (int k = 0; k < 2; ++k) dst[n][k] = *(const PG8_LAS bf16x8*)(lds + PG8_SB(b, h) + boff + n * 2048 + k * 1024); } while (0)
#define PG8_MMA(ai, bj, At, Bt) do { __builtin_amdgcn_s_setprio(1); _Pragma("unroll") for (int m = 0; m < 4; ++m) _Pragma("unroll") for (int n = 0; n < 2; ++n) _Pragma("unroll") for (int k = 0; k < 2; ++k) \
        acc[ai][bj][m][n] = __builtin_amdgcn_mfma_f32_16x16x32_bf16(Bt[n][k], At[m][k], acc[ai][bj][m][n], 0, 0, 0); __builtin_amdgcn_s_setprio(0); } while (0)
#define PG8_WAIT_V(n) asm volatile("s_waitcnt vmcnt(" #n ")" ::: "memory")
#define PG8_WAIT_L(n) asm volatile("s_waitcnt lgkmcnt(" #n ")" ::: "memory")
#define PG8_BAR __builtin_amdgcn_s_barrier()
#define PG8_SCHED __builtin_amdgcn_sched_barrier(0)
    Unit cur, nxt; int ui = 0;
    if (!S.next(0, cur)) return;
    f32x4 acc[2][2][4][2];
#pragma unroll
    for (int a = 0; a < 2; ++a)
#pragma unroll
        for (int b = 0; b < 2; ++b)
#pragma unroll
            for (int m = 0; m < 4; ++m)
#pragma unroll
                for (int n = 0; n < 2; ++n) acc[a][b][m][n] = (f32x4){0.f, 0.f, 0.f, 0.f};
    bf16x8 At[4][2], B0[2][2], B1[2][2];
    const char* cA = (const char*)g.A + (size_t)cur.pm * tstep; const char* cB = (const char*)g.Bt + (size_t)cur.pn * tstep;
    S.a_ready(cur);
    if constexpr (SP2) {
        PG8_STAGE(PG8_SB(0, 0), cB, voffB); PG8_STAGE(PG8_SB(0, 1), cB + hstep, voffB); PG8_STAGE(PG8_SA(0, 0), cA, voffA); PG8_STAGE(PG8_SA(0, 1), cA + hstep, voffA);
        if (wr == 1) PG8_BAR;
        PG8_WAIT_V(2); PG8_BAR;
        PG8_STAGE(PG8_SB(1, 0), cB + kstep, voffB); PG8_STAGE(PG8_SA(1, 0), cA + kstep, voffA); PG8_STAGE(PG8_SB(1, 1), cB + hstep + kstep, voffB);
        PG8_WAIT_V(6); PG8_BAR;
    } else {
        PG8_STAGE(PG8_SB(0, 0), cB, voffB); PG8_STAGE(PG8_SA(0, 0), cA, voffA); PG8_STAGE(PG8_SB(0, 1), cB + hstep, voffB); PG8_STAGE(PG8_SA(0, 1), cA + hstep, voffA);
        if (wr == 1) PG8_BAR;
        PG8_WAIT_V(4); PG8_BAR;
        PG8_STAGE(PG8_SB(1, 0), cB + kstep, voffB); PG8_STAGE(PG8_SA(1, 0), cA + kstep, voffA); PG8_STAGE(PG8_SB(1, 1), cB + hstep + kstep, voffB);
        PG8_WAIT_V(6); PG8_BAR;
    }
    for (;;) {
        const bool has_next = S.next(ui + 1, nxt);
        const char* nA = has_next ? (const char*)g.A + (size_t)nxt.pm * tstep : cA; const char* nB = has_next ? (const char*)g.Bt + (size_t)nxt.pn * tstep : cB;
        for (int t = 0; t < nt; t += 2) {
            const bool last = (t == nt - 2);
            const char* a1 = cA + (size_t)(t + 1) * kstep;
            const char* a2 = last ? nA : cA + (size_t)(t + 2) * kstep; const char* b2 = last ? nB : cB + (size_t)(t + 2) * kstep;
            const char* a3 = a2 + kstep; const char* b3 = b2 + kstep;
            if (last && has_next) S.a_ready(nxt);
            if constexpr (SP2) {
            PG8_LDB(B0, 0, 0); PG8_LDB(B1, 0, 1); PG8_SCHED; PG8_LDA(At, 0, 0); PG8_STAGE(PG8_SA(1, 1), a1 + hstep, voffA);
            PG8_WAIT_V(8); PG8_WAIT_L(0); PG8_BAR; PG8_MMA(0, 0, At, B0); PG8_MMA(0, 1, At, B1); PG8_BAR; PG8_SCHED;
            PG8_LDA(At, 0, 1); PG8_STAGE(PG8_SB(0, 0), b2, voffB); PG8_STAGE(PG8_SB(0, 1), b2 + hstep, voffB); PG8_STAGE(PG8_SA(0, 0), a2, voffA);
            PG8_WAIT_V(8); PG8_WAIT_L(0); PG8_BAR; PG8_MMA(1, 0, At, B0); PG8_MMA(1, 1, At, B1); PG8_BAR; PG8_SCHED;
            PG8_LDB(B0, 1, 0); PG8_LDB(B1, 1, 1); PG8_SCHED; PG8_LDA(At, 1, 0); PG8_STAGE(PG8_SA(0, 1), a2 + hstep, voffA);
            PG8_WAIT_V(8); PG8_WAIT_L(0); PG8_BAR; PG8_MMA(0, 0, At, B0); PG8_MMA(0, 1, At, B1); PG8_BAR; PG8_SCHED;
            PG8_LDA(At, 1, 1); PG8_STAGE(PG8_SB(1, 0), b3, voffB); PG8_STAGE(PG8_SB(1, 1), b3 + hstep, voffB); PG8_STAGE(PG8_SA(1, 0), a3, voffA);
            PG8_WAIT_V(8); PG8_WAIT_L(0); PG8_BAR; PG8_MMA(1, 0, At, B0); PG8_MMA(1, 1, At, B1); PG8_BAR; PG8_SCHED;
            } else {
            PG8_LDB(B0, 0, 0); PG8_SCHED; PG8_LDA(At, 0, 0); PG8_STAGE(PG8_SA(1, 1), a1 + hstep, voffA);
            PG8_WAIT_L(8); PG8_BAR; PG8_WAIT_L(0); PG8_MMA(0, 0, At, B0); PG8_BAR; PG8_SCHED;
            PG8_LDB(B1, 0, 1); PG8_STAGE(PG8_SB(0, 0), b2, voffB);
            PG8_BAR; PG8_WAIT_L(0); PG8_MMA(0, 1, At, B1); PG8_BAR;
            PG8_LDA(At, 0, 1); PG8_STAGE(PG8_SA(0, 0), a2, voffA);
            PG8_BAR; PG8_WAIT_L(0); PG8_MMA(1, 0, At, B0); PG8_BAR; PG8_SCHED;
            PG8_STAGE(PG8_SB(0, 1), b2 + hstep, voffB);
            PG8_WAIT_V(6); PG8_BAR; PG8_MMA(1, 1, At, B1); PG8_BAR;
            PG8_LDB(B0, 1, 0); PG8_SCHED; PG8_LDA(At, 1, 0); PG8_STAGE(PG8_SA(0, 1), a2 + hstep, voffA);
            PG8_WAIT_L(8); PG8_BAR; PG8_WAIT_L(0); PG8_MMA(0, 0, At, B0); PG8_BAR; PG8_SCHED;
            PG8_LDB(B1, 1, 1); PG8_STAGE(PG8_SB(1, 0), b3, voffB);
            PG8_BAR; PG8_WAIT_L(0); PG8_MMA(0, 1, At, B1); PG8_BAR;
            PG8_LDA(At, 1, 1); PG8_STAGE(PG8_SA(1, 0), a3, voffA);
            PG8_BAR; PG8_WAIT_L(0); PG8_MMA(1, 0, At, B0); PG8_BAR; PG8_SCHED;
            PG8_STAGE(PG8_SB(1, 1), b3 + hstep, voffB);
            PG8_WAIT_V(6); PG8_BAR; PG8_MMA(1, 1, At, B1); PG8_BAR;
            }
        }
        if constexpr (ALIGN_EPI) { if (wr == 0) PG8_BAR; }
        if constexpr (!Epi::AFTER_DRAIN) { E(acc, cur, wr, wc, fr, fq); S.done(cur); }
        if (!has_next) break;
#pragma unroll
        for (int a = 0; a < 2; ++a)
#pragma unroll
            for (int b = 0; b < 2; ++b)
#pragma unroll
                for (int m = 0; m < 4; ++m)
#pragma unroll
                    for (int n = 0; n < 2; ++n) acc[a][b][m][n] = (f32x4){0.f, 0.f, 0.f, 0.f};
        cur = nxt; cA = nA; cB = nB; ++ui;
        if constexpr (ALIGN_EPI) { if (wr == 1) PG8_BAR; }
    }
    PG8_WAIT_V(0);
    if constexpr (!ALIGN_EPI) { if (wr == 0) PG8_BAR; }
    PG8_BAR;
    if constexpr (Epi::AFTER_DRAIN) { E.fused(acc, cur, wr, wc, fr, fq, lds, wid, lane); S.done(cur); }
#undef PG8_SA
#undef PG8_SB
#undef PG8_STAGE
#undef PG8_LDA
#undef PG8_LDB
#undef PG8_MMA
#undef PG8_WAIT_V
#undef PG8_WAIT_L
#undef PG8_BAR
#undef PG8_SCHED
}
}
namespace mix {
using bf16 = unsigned short;
using bf16x8 = __attribute__((ext_vector_type(8))) short;
using s16x4  = __attribute__((ext_vector_type(4))) short;
using f32x16 = __attribute__((ext_vector_type(16))) float;
using u32x4  = __attribute__((ext_vector_type(4))) unsigned;
constexpr int NW = 8, QBLK = 32, KVBLK = 64, SEQ = 8192;
constexpr int SHM_V = KVBLK * 128 * 2, SHM_K = KVBLK * 128 * 2, MIX_LDS = 2 * SHM_V + 2 * SHM_K + NW * 64 * 4;
#define KSWZ(row, colB) ((row) * 256 + ((colB) ^ (((row) & 7) << 4)))
#define SBAR() __builtin_amdgcn_sched_barrier(0)
__device__ __forceinline__ int crow(int r, int hi) { return (r & 3) + 8 * (r >> 2) + 4 * hi; }
__device__ __forceinline__ unsigned cvtpk(float lo, float hi) { unsigned r; asm volatile("v_cvt_pk_bf16_f32 %0, %1, %2" : "=v"(r) : "v"(lo), "v"(hi)); return r; }
__device__ __forceinline__ float bf2f(unsigned short b) { return __uint_as_float((unsigned)b << 16); }
__device__ __forceinline__ unsigned short f2bf(float f) { return (unsigned short)(cvtpk(f, f) & 0xffffu); }
__device__ __forceinline__ int v_st(int k, int c) { const int kk = (k & ~0xC) | ((k & 4) << 1) | ((k & 8) >> 1); return ((kk >> 3) * 4 + (c >> 5)) * 512 + ((kk & 7) * 32 + (c & 31)) * 2; }
__device__ __forceinline__ int v_rd_base(int lane) { return ((lane & 3) << 3) | (((lane >> 2) & 3) << 6) | (((lane >> 4) & 1) << 5) | (((lane >> 5) & 1) << 8); }
constexpr int v_rd_off(int d0, int ks, int half) { return d0 * 512 + ks * 4096 + half * 2048; }
template <int OFF> __device__ __forceinline__ s16x4 tr_read(int vb) {
  s16x4 r; asm volatile("ds_read_b64_tr_b16 %0, %1 offset:%2" : "=&v"(r) : "v"(vb), "i"(OFF) : "memory"); return r;
}
template <int D0> __device__ __forceinline__ void pv_one(f32x16& od, int vb, bf16x8 pa0, bf16x8 pa1, bf16x8 pa2, bf16x8 pa3) {
  const s16x4 l0 = tr_read<v_rd_off(D0, 0, 0)>(vb), h0 = tr_read<v_rd_off(D0, 0, 1)>(vb), l1 = tr_read<v_rd_off(D0, 1, 0)>(vb), h1 = tr_read<v_rd_off(D0, 1, 1)>(vb);
  const s16x4 l2 = tr_read<v_rd_off(D0, 2, 0)>(vb), h2 = tr_read<v_rd_off(D0, 2, 1)>(vb), l3 = tr_read<v_rd_off(D0, 3, 0)>(vb), h3 = tr_read<v_rd_off(D0, 3, 1)>(vb);
  asm volatile("s_waitcnt lgkmcnt(0)" ::: "memory"); SBAR();
#define PK(L, H) (bf16x8){L[0], L[1], L[2], L[3], H[0], H[1], H[2], H[3]}
  od = __builtin_amdgcn_mfma_f32_32x32x16_bf16(pa0, PK(l0, h0), od, 0, 0, 0);
  od = __builtin_amdgcn_mfma_f32_32x32x16_bf16(pa1, PK(l1, h1), od, 0, 0, 0);
  od = __builtin_amdgcn_mfma_f32_32x32x16_bf16(pa2, PK(l2, h2), od, 0, 0, 0);
  od = __builtin_amdgcn_mfma_f32_32x32x16_bf16(pa3, PK(l3, h3), od, 0, 0, 0);
#undef PK
}
__device__ __forceinline__ void pv_d0(f32x16* o, int vb, bf16x8 pa0, bf16x8 pa1, bf16x8 pa2, bf16x8 pa3) {
  pv_one<0>(o[0], vb, pa0, pa1, pa2, pa3); pv_one<1>(o[1], vb, pa0, pa1, pa2, pa3); pv_one<2>(o[2], vb, pa0, pa1, pa2, pa3); pv_one<3>(o[3], vb, pa0, pa1, pa2, pa3);
}
template <int ND> __device__ __forceinline__ void qkt(f32x16& p0, f32x16& p1, const char* Ks, const bf16x8* qr, int r32, int hi, int dbase, const f32x16& cinit) {
  p0 = cinit; p1 = cinit;
#pragma unroll
  for (int d0 = 0; d0 < ND; ++d0) { const int cb = ((dbase + d0) * 16 + hi * 8) * 2;
    const bf16x8 b0 = *reinterpret_cast<const bf16x8*>(Ks + KSWZ(r32, cb));
    const bf16x8 b1 = *reinterpret_cast<const bf16x8*>(Ks + KSWZ(32 + r32, cb));
    p0 = __builtin_amdgcn_mfma_f32_32x32x16_bf16(b0, qr[d0], p0, 0, 0, 0);
    p1 = __builtin_amdgcn_mfma_f32_32x32x16_bf16(b1, qr[d0], p1, 0, 0, 0); }
}
__device__ __forceinline__ void packP(const f32x16& p0, const f32x16& p1, bf16x8& pa0, bf16x8& pa1, bf16x8& pa2, bf16x8& pa3) {
#define PK4(P, BASE, OUT) do { unsigned a0 = cvtpk(P[BASE + 0], P[BASE + 1]), a1 = cvtpk(P[BASE + 2], P[BASE + 3]);   \
    unsigned b0 = cvtpk(P[BASE + 4], P[BASE + 5]), b1 = cvtpk(P[BASE + 6], P[BASE + 7]);                              \
    auto r0 = __builtin_amdgcn_permlane32_swap(a0, b0, false, false); auto r1 = __builtin_amdgcn_permlane32_swap(a1, b1, false, false); \
    u32x4 w = {r0[0], r1[0], r0[1], r1[1]}; OUT = *reinterpret_cast<bf16x8*>(&w); } while (0)
  PK4(p0, 0, pa0); PK4(p0, 8, pa1); PK4(p1, 0, pa2); PK4(p1, 8, pa3);
#undef PK4
}
struct MixArgs {
  const bf16* DQ; const bf16* DK; const bf16* RQ; const bf16* RK; const bf16* PROJ; bf16* MIXED;
  const bf16* RKF; const bf16* RKB; float* KVT; const bf16* ST;
  const float* dnw;
  const float* rnw;
  float lam;
  float shift;
  const float* ldf; const float* ldb;
};
template <int MODE>
__device__ __forceinline__ void mixer_unit(const MixArgs& A, int b, int h, int qb, char* lds) {
  const int tid = ltid(), wid = __builtin_amdgcn_readfirstlane(tid >> 6), lane = tid & 63, r32 = lane & 31, hi = lane >> 5;
  char* V_lds = lds; char* K_lds = lds + 2 * SHM_V;
  float* ws = (float*)(lds + 2 * SHM_V + 2 * SHM_K) + wid * 64;
  constexpr int ND = MODE == 0 ? 4 : 8;
  const int c = MODE == 0 ? (wid >> 2) : 0, wq = MODE == 0 ? (wid & 3) : wid;
  const int q0 = qb * (MODE == 0 ? 128 : 256);
  const long tok0 = (long)b * SEQ;
  const bf16* Qw; const bf16* Kh; const bf16* Vh; int LDK;
  if (MODE == 0) { Qw = A.DQ + (tok0 + q0 + wq * QBLK + r32) * 512 + h * 128 + c * 64 + hi * 8; Kh = A.DK + tok0 * 512 + h * 128; LDK = 512; Vh = A.PROJ + tok0 * 3584 + 3072 + h * 128; }
  else           { Qw = A.RQ + ((long)(b * 4 + h) * SEQ + q0 + wq * QBLK + r32) * 128 + hi * 8; Kh = A.RK + (long)(b * 4 + h) * SEQ * 128; LDK = 128; Vh = A.PROJ + tok0 * 3584 + 1024 + h * 128; }
  constexpr int LDV = 3584;
  bf16x8 qr[ND];
#pragma unroll
  for (int d0 = 0; d0 < ND; ++d0) qr[d0] = *reinterpret_cast<const bf16x8*>(Qw + d0 * 16);
  const int sr = tid >> 4, sc = (tid & 15) * 8, vst0 = v_st(sr, sc), vst1 = v_st(32 + sr, sc);
  const int vb0 = (int)(uintptr_t)V_lds + v_rd_base(lane);
  bf16x8 vs0, vs1, ks0, ks1;
#define SLOAD(k0) do { vs0 = *reinterpret_cast<const bf16x8*>(&Vh[(long)((k0) + sr) * LDV + sc]); vs1 = *reinterpret_cast<const bf16x8*>(&Vh[(long)((k0) + 32 + sr) * LDV + sc]); \
    ks0 = *reinterpret_cast<const bf16x8*>(&Kh[(long)((k0) + sr) * LDK + sc]); ks1 = *reinterpret_cast<const bf16x8*>(&Kh[(long)((k0) + 32 + sr) * LDK + sc]); } while (0)
#define SWRITE(bb) do { *(bf16x8*)(V_lds + (bb) * SHM_V + vst0) = vs0; *(bf16x8*)(V_lds + (bb) * SHM_V + vst1) = vs1; const int kc = sc * 2; \
    *(bf16x8*)(K_lds + (bb) * SHM_K + KSWZ(sr, kc)) = ks0; *(bf16x8*)(K_lds + (bb) * SHM_K + KSWZ(32 + sr, kc)) = ks1; } while (0)
  f32x16 o[4] = {};
  float l = 0.f;
  constexpr int NT = SEQ / KVBLK;
  f32x16 cinit;
#pragma unroll
  for (int r = 0; r < 16; ++r) cinit[r] = MODE == 0 ? -A.shift : 0.f;
  if (MODE == 0) asm volatile("" : "+v"(cinit));
  const int nq = q0 + wq * QBLK + r32;
  float ldf = 0.f, nldb = 0.f;
  if (MODE == 1) { ldf = A.ldf[h] * 1.4426950408889634f; nldb = -A.ldb[h] * 1.4426950408889634f; }
  const int jlo = MODE == 1 ? 4 * qb : 0, jhi = MODE == 1 ? jlo + 4 : NT;
  SLOAD(jlo * KVBLK);
  if (MODE == 1) {
    const float nl = (float)(wq * QBLK + r32);
#pragma unroll
    for (int dir = 0; dir < 2; ++dir) {
      const float scl = dir == 0 ? __builtin_amdgcn_exp2f(ldf * (nl + 1.0f)) : __builtin_amdgcn_exp2f(-nldb * (256.0f - nl));
      bf16x8 qs[8];
#pragma unroll
      for (int d0 = 0; d0 < 8; ++d0) { const u32x4 w = *reinterpret_cast<const u32x4*>(&qr[d0]); u32x4 z;
#pragma unroll
        for (int i = 0; i < 4; ++i) z[i] = cvtpk(__uint_as_float(w[i] << 16) * scl, __uint_as_float(w[i] & 0xffff0000u) * scl);
        qs[d0] = *reinterpret_cast<const bf16x8*>(&z); }
      const bf16* STp = A.ST + ((size_t)((b * 4 + h) * 2 + dir) * 32 + qb) * 16384 + (size_t)r32 * 128 + hi * 8;
#pragma unroll
      for (int dvb = 0; dvb < 4; ++dvb)
#pragma unroll
        for (int d0 = 0; d0 < 8; ++d0) { const bf16x8 fr = *reinterpret_cast<const bf16x8*>(STp + dvb * 32 * 128 + d0 * 16);
          o[dvb] = __builtin_amdgcn_mfma_f32_32x32x16_bf16(qs[d0], fr, o[dvb], 0, 0, 0); }
    }
  }
  asm volatile("s_waitcnt vmcnt(0)" ::: "memory"); SWRITE(jlo & 1); __syncthreads();
  for (int j = jlo; j < jhi; ++j) {
    const int buf = j & 1;
    if (j + 1 < jhi) SLOAD((j + 1) * KVBLK);
    const char* Ks = K_lds + buf * SHM_K; const int vb = vb0 + buf * SHM_V;
    f32x16 p0, p1; bf16x8 pa0, pa1, pa2, pa3;
    qkt<ND>(p0, p1, Ks, qr, r32, hi, c * 4, cinit);
    if (MODE == 0) {
      float ps = 0.f;
#pragma unroll
      for (int r = 0; r < 16; ++r) { float a = p0[r], e = p1[r]; a = __builtin_amdgcn_exp2f(a); e = __builtin_amdgcn_exp2f(e); p0[r] = a; p1[r] = e; ps += a + e; }
      l += ps;
    } else {
      const float dbase = (float)(nq - j * KVBLK - 4 * hi);
#pragma unroll
      for (int r = 0; r < 16; ++r) { const float d = dbase - (float)((r & 3) + 8 * (r >> 2)), d2 = d - 32.0f;
        p0[r] *= __builtin_amdgcn_exp2f(d * (d >= 0.f ? ldf : nldb));
        p1[r] *= __builtin_amdgcn_exp2f(d2 * (d2 >= 0.f ? ldf : nldb)); }
    }
    packP(p0, p1, pa0, pa1, pa2, pa3);
    pv_d0(o, vb, pa0, pa1, pa2, pa3);
    if (j + 1 < jhi) { asm volatile("s_waitcnt vmcnt(0)" ::: "memory"); SWRITE(buf ^ 1); }
    __syncthreads();
  }
#undef SLOAD
#undef SWRITE
  const long trow0 = tok0 + q0 + wq * QBLK;
  if (MODE == 0) {
    { auto rr = __builtin_amdgcn_permlane32_swap(__float_as_uint(l), __float_as_uint(l), false, false); l = __uint_as_float(rr[0]) + __uint_as_float(rr[1]); }
    if (hi == 0) ws[r32] = (c == 0 ? 1.0f : A.lam) / l;
    asm volatile("s_waitcnt lgkmcnt(0)" ::: "memory");
    float* xb = (float*)lds + (wq * QBLK) * 128;
    if (c == 1) {
#pragma unroll
      for (int r = 0; r < 16; ++r) { const int orow = crow(r, hi); const float a1 = ws[orow];
#pragma unroll
        for (int d0 = 0; d0 < 4; ++d0) xb[orow * 128 + d0 * 32 + r32] = o[d0][r] * a1; }
    }
    __syncthreads();
    if (c == 0) {
#pragma unroll
      for (int r = 0; r < 16; ++r) { const int orow = crow(r, hi); const float a0 = ws[orow];
        float v[4]; float ss = 0.f;
#pragma unroll
        for (int d0 = 0; d0 < 4; ++d0) { v[d0] = o[d0][r] * a0 - xb[orow * 128 + d0 * 32 + r32]; ss += v[d0] * v[d0]; }
        ss += __shfl_xor(ss, 1); ss += __shfl_xor(ss, 2); ss += __shfl_xor(ss, 4); ss += __shfl_xor(ss, 8); ss += __shfl_xor(ss, 16);
        const float rstd = 0.8f * rsqrtf(ss * (1.0f / 128.0f) + 1e-6f);
        bf16* orp = A.MIXED + (trow0 + orow) * 1024 + 512 + h * 128;
#pragma unroll
        for (int d0 = 0; d0 < 4; ++d0) orp[d0 * 32 + r32] = f2bf(v[d0] * rstd * A.dnw[d0 * 32 + r32]); }
    }
  } else {
#pragma unroll
    for (int r = 0; r < 16; ++r) { const int orow = crow(r, hi);
      float v[4]; float ss = 0.f;
#pragma unroll
      for (int d0 = 0; d0 < 4; ++d0) { v[d0] = o[d0][r]; ss += v[d0] * v[d0]; }
      ss += __shfl_xor(ss, 1); ss += __shfl_xor(ss, 2); ss += __shfl_xor(ss, 4); ss += __shfl_xor(ss, 8); ss += __shfl_xor(ss, 16);
      const float rstd = rsqrtf(ss * (1.0f / 128.0f) + 1e-6f);
      bf16* orp = A.MIXED + (trow0 + orow) * 1024 + h * 128;
      const bf16* grp = A.PROJ + (trow0 + orow) * 3584 + 1536 + h * 128;
#pragma unroll
      for (int d0 = 0; d0 < 4; ++d0) { const float g = bf2f(grp[d0 * 32 + r32]); const float sg = g / (1.0f + __expf(-g));
        orp[d0 * 32 + r32] = f2bf(v[d0] * rstd * A.rnw[h * 128 + d0 * 32 + r32] * sg); } }
  }
  __syncthreads();
}

__device__ __forceinline__ s16x4 tr_read_rt(int addr) { s16x4 r; asm volatile("ds_read_b64_tr_b16 %0, %1" : "=&v"(r) : "v"(addr) : "memory"); return r; }
__device__ __forceinline__ void kv_unit(const MixArgs& A, int b, int h, int ch, char* lds) {
  const int tid = ltid(), wid = __builtin_amdgcn_readfirstlane(tid >> 6), lane = tid & 63, r32 = lane & 31, hi = lane >> 5;
  constexpr int IMG = 16384, BUFB = 3 * IMG;
  const long tok0 = (long)b * SEQ; const int k0 = ch * 256;
  const bf16* Vh = A.PROJ + tok0 * 3584 + 1024 + h * 128; const bf16* KFh = A.RKF + (long)(b * 4 + h) * SEQ * 128; const bf16* KBh = A.RKB + (long)(b * 4 + h) * SEQ * 128;
  const int sr = tid >> 4, sc = (tid & 15) * 8, vst0 = v_st(sr, sc), vst1 = v_st(32 + sr, sc);
  const int dir = wid >> 2, dkb = wid & 3;
  bf16x8 s0, s1, s2, s3, s4, s5;
#define KLOAD(kk) do { s0 = *reinterpret_cast<const bf16x8*>(&Vh[(long)((kk) + sr) * 3584 + sc]); s1 = *reinterpret_cast<const bf16x8*>(&Vh[(long)((kk) + 32 + sr) * 3584 + sc]); \
    s2 = *reinterpret_cast<const bf16x8*>(&KFh[(long)((kk) + sr) * 128 + sc]); s3 = *reinterpret_cast<const bf16x8*>(&KFh[(long)((kk) + 32 + sr) * 128 + sc]); \
    s4 = *reinterpret_cast<const bf16x8*>(&KBh[(long)((kk) + sr) * 128 + sc]); s5 = *reinterpret_cast<const bf16x8*>(&KBh[(long)((kk) + 32 + sr) * 128 + sc]); } while (0)
#define KWRITE(bb) do { char* p_ = lds + (bb) * BUFB; *(bf16x8*)(p_ + vst0) = s0; *(bf16x8*)(p_ + vst1) = s1; *(bf16x8*)(p_ + IMG + vst0) = s2; *(bf16x8*)(p_ + IMG + vst1) = s3; \
    *(bf16x8*)(p_ + 2 * IMG + vst0) = s4; *(bf16x8*)(p_ + 2 * IMG + vst1) = s5; } while (0)
  f32x16 acc[4] = {};
  KLOAD(k0); asm volatile("s_waitcnt vmcnt(0)" ::: "memory"); KWRITE(0); __syncthreads();
  const int rdb = (int)(uintptr_t)lds + v_rd_base(lane);
  for (int j = 0; j < 4; ++j) {
    const int buf = j & 1;
    if (j + 1 < 4) KLOAD(k0 + (j + 1) * KVBLK);
    const int vb = rdb + buf * BUFB, kb = rdb + buf * BUFB + IMG * (1 + dir) + dkb * 512;
#pragma unroll
    for (int ks = 0; ks < 4; ++ks) {
      const s16x4 kl = tr_read_rt(kb + ks * 4096), kh = tr_read_rt(kb + ks * 4096 + 2048);
      s16x4 vl[4], vh[4];
#pragma unroll
      for (int dvb = 0; dvb < 4; ++dvb) { vl[dvb] = tr_read_rt(vb + dvb * 512 + ks * 4096); vh[dvb] = tr_read_rt(vb + dvb * 512 + ks * 4096 + 2048); }
      asm volatile("s_waitcnt lgkmcnt(0)" ::: "memory"); SBAR();
      const bf16x8 ka = (bf16x8){kl[0], kl[1], kl[2], kl[3], kh[0], kh[1], kh[2], kh[3]};
#pragma unroll
      for (int dvb = 0; dvb < 4; ++dvb) { const bf16x8 vf = (bf16x8){vl[dvb][0], vl[dvb][1], vl[dvb][2], vl[dvb][3], vh[dvb][0], vh[dvb][1], vh[dvb][2], vh[dvb][3]};
        acc[dvb] = __builtin_amdgcn_mfma_f32_32x32x16_bf16(ka, vf, acc[dvb], 0, 0, 0); }
    }
    if (j + 1 < 4) { asm volatile("s_waitcnt vmcnt(0)" ::: "memory"); KWRITE(buf ^ 1); }
    __syncthreads();
  }
#undef KLOAD
#undef KWRITE
  float* outp = A.KVT + ((size_t)((b * 4 + h) * 2 + dir) * 32 + ch) * 16384;
  using f32x4v = __attribute__((ext_vector_type(4))) float;
#pragma unroll
  for (int dvb = 0; dvb < 4; ++dvb)
#pragma unroll
    for (int g = 0; g < 4; ++g) { const f32x4v v = {acc[dvb][4 * g], acc[dvb][4 * g + 1], acc[dvb][4 * g + 2], acc[dvb][4 * g + 3]};
      *(f32x4v*)(outp + (size_t)(dvb * 32 + r32) * 128 + dkb * 32 + 8 * g + 4 * hi) = v; }
}
#undef SBAR
}
constexpr int NWAVES = 8;
constexpr int BATCH = 2, SEQ = 8192, DM = 1024, T = BATCH * SEQ, NPROJ = 3584, NEXP = 32, TOPK = 4, DFF = 1024;
constexpr float EPS = 1e-6f;
constexpr int MAXROWS = 73728;
constexpr int MAXTILES = MAXROWS / 256;
constexpr size_t MiB = 1u << 20;
constexpr size_t WS_CTL = 0, CTL_ZERO_BYTES = 1 * MiB;
constexpr size_t WS_WIN = 2 * MiB;
constexpr size_t WS_WOUT = 10 * MiB;
constexpr size_t WS_W1 = 16 * MiB;
constexpr size_t WS_W2 = 144 * MiB;
constexpr size_t WS_XN = 208 * MiB;
constexpr size_t WS_PROJ = 240 * MiB;
constexpr size_t WS_RQ = 352 * MiB, WS_RK = 368 * MiB, WS_DQ = 384 * MiB, WS_DK = 400 * MiB;
constexpr size_t WS_MIXED = 416 * MiB;
constexpr size_t WS_H2 = 448 * MiB;
constexpr size_t WS_SEL = 480 * MiB;
constexpr size_t WS_SLOT = WS_SEL + 256 * 1024;
constexpr size_t WS_GATE = WS_SLOT + 256 * 1024;
constexpr size_t WS_ROWS = WS_GATE + 256 * 1024;
constexpr size_t WS_GATEP = WS_ROWS + 256 * 1024;
constexpr size_t WS_XG = 482 * MiB;
constexpr size_t WS_RKF = 482 * MiB, WS_RKB = 498 * MiB, WS_KVT = 514 * MiB, WS_ST = 546 * MiB;
constexpr size_t WS_ACT = WS_PROJ;
constexpr size_t WS_X1 = 626 * MiB;
constexpr size_t WS_END = 690 * MiB;
static_assert(WS_GATEP + MAXROWS * 4 <= WS_XG && WS_ACT + (size_t)MAXROWS * 2048 <= WS_DQ && WS_XG + (size_t)MAXROWS * 2048 <= WS_END, "d_ws map");
constexpr int CW_CNT = 8192;
constexpr int CW_BAR = 4096;
constexpr int RING_OFF = 0, RING_BYTES = 131072;
constexpr int LDS_BYTES = 162816;
constexpr int MISC_OFF = 151552;
constexpr int TAB_OFF = 152064;
constexpr int ROUTE_OFF = 153600;
static_assert(TAB_OFF + 34 * 4 + MAXTILES <= ROUTE_OFF && ROUTE_OFF + 256 + 64 * 4 * 8 <= LDS_BYTES, "LDS map");

#define GAS __attribute__((address_space(1)))
#define LAS __attribute__((address_space(3)))
typedef unsigned short bf16;
typedef unsigned v4u __attribute__((ext_vector_type(4)));
typedef unsigned v2u __attribute__((ext_vector_type(2)));
typedef float f32x4 __attribute__((ext_vector_type(4)));
typedef float f32x2 __attribute__((ext_vector_type(2)));
typedef short bf16x8 __attribute__((ext_vector_type(8)));
typedef GAS unsigned gu32;
#define RLX_AGENT __ATOMIC_RELAXED, __HIP_MEMORY_SCOPE_AGENT
#define LDS_WAIT() asm volatile("s_waitcnt lgkmcnt(0)" ::: "memory")
#define VM_WAIT() asm volatile("s_waitcnt vmcnt(0)" ::: "memory")
__device__ __forceinline__ unsigned pk2(float lo, float hi) { unsigned r; asm volatile("v_cvt_pk_bf16_f32 %0, %1, %2" : "=v"(r) : "v"(lo), "v"(hi)); return r; }
__device__ __forceinline__ float bflo(unsigned w) { return __uint_as_float(w << 16); }
__device__ __forceinline__ float bfhi(unsigned w) { return __uint_as_float(w & 0xffff0000u); }
__device__ __forceinline__ float wave_sum(float v) {
#pragma unroll
    for (int o = 1; o < 64; o <<= 1) v += __shfl_xor(v, o);
    return v;
}
__device__ __forceinline__ float wave_max(float v) {
#pragma unroll
    for (int o = 1; o < 64; o <<= 1) v = fmaxf(v, __shfl_xor(v, o));
    return v;
}
#define XB_TMO      128
#define XB_XCNT(j)  (256  + 64 * (j))
#define XB_XSUB(j)  (1280 + 64 * (j))
#define XB_XGEN(j)  (2304 + 64 * (j))
#define XB_TOP      3328
#define XB_TOPGEN   3392
#define XCD_BAR_WORDS 3456
#define XB_SPIN_CAP (1u << 18)

__device__ __forceinline__ unsigned xb_ld(unsigned* p)              { return __hip_atomic_load(p, __ATOMIC_RELAXED, __HIP_MEMORY_SCOPE_AGENT); }
__device__ __forceinline__ unsigned xb_add(unsigned* p, unsigned v) { return __hip_atomic_fetch_add(p, v, __ATOMIC_RELAXED, __HIP_MEMORY_SCOPE_AGENT); }
__device__ __forceinline__ unsigned xb_xcc_id() { return (unsigned)__builtin_amdgcn_s_getreg((3 << 11) | 20) & 0xFu; }
#define XB_SPIN(cond, bar) do { unsigned _sp = 0; while (cond) { __builtin_amdgcn_s_sleep(1); \
    if ((++_sp & 255u) == 0u) { if (xb_ld(&(bar)[XB_TMO])) break; if (_sp > XB_SPIN_CAP) { atomicAdd(&(bar)[XB_TMO], 1u); break; } } } } while (0)

struct XcdBarrier {
    unsigned* bar; unsigned x;
    volatile LAS unsigned* st;
};

__device__ __forceinline__ XcdBarrier xcd_barrier_post(unsigned* bar, volatile LAS unsigned* st) {
    XcdBarrier b; b.bar = bar; b.x = xb_xcc_id(); b.st = st;
    if (threadIdx.x == 0) (void)xb_add(&bar[XB_XCNT(b.x)], 1u);
    return b;
}
__device__ __forceinline__ void xcd_barrier_complete(unsigned* bar, unsigned x, unsigned& nloc, unsigned& nx) {
    const unsigned G = gridDim.x * gridDim.y * gridDim.z;
    unsigned sum, cnt, mine, sp = 0u;
    for (;;) {
        sum = 0u; cnt = 0u; mine = 0u;
#pragma unroll
        for (unsigned j = 0; j < 16; ++j) { const unsigned c = xb_ld(&bar[XB_XCNT(j)]); sum += c; cnt += (c > 0u) ? 1u : 0u; mine = (j == x) ? c : mine; }
        if (sum == G) break;
        __builtin_amdgcn_s_sleep(1);
        if ((++sp & 255u) == 0u) { if (xb_ld(&bar[XB_TMO])) break; if (sp > XB_SPIN_CAP) { atomicAdd(&bar[XB_TMO], 1u); break; } }
    }
    nloc = mine > 0u ? mine : 1u; nx = cnt > 0u ? cnt : 1u;
}

__device__ __forceinline__ void xcd_barrier(const XcdBarrier& b) {
    asm volatile("s_waitcnt vmcnt(0)" ::: "memory");
    __syncthreads();
    if (threadIdx.x == 0) {
        unsigned* bar = b.bar;
        __builtin_amdgcn_s_waitcnt(0);
        unsigned nloc = b.st[0], nx = b.st[1];
        if (nloc == 0u) { xcd_barrier_complete(bar, b.x, nloc, nx); b.st[0] = nloc; b.st[1] = nx; }
        const unsigned old = xb_add(&bar[XB_XSUB(b.x)], 1u);
        const unsigned gen = old / nloc;
        if (old + 1u == (gen + 1u) * nloc) {
            __builtin_amdgcn_fence(__ATOMIC_RELEASE, "agent");
            asm volatile("s_waitcnt vmcnt(0)" ::: "memory");
            const unsigned og = xb_add(&bar[XB_TOP], 1u);
            const unsigned tg = og / nx;
            if (og + 1u == (tg + 1u) * nx) xb_add(&bar[XB_TOPGEN], 1u);
            else XB_SPIN(xb_ld(&bar[XB_TOPGEN]) == tg, bar);
            __builtin_amdgcn_fence(__ATOMIC_ACQUIRE, "agent");
            xb_add(&bar[XB_XGEN(b.x)], 1u);
            asm volatile("s_waitcnt vmcnt(0)" ::: "memory");
        } else {
            XB_SPIN(xb_ld(&bar[XB_XGEN(b.x)]) == gen, bar);
            __builtin_amdgcn_fence(__ATOMIC_ACQUIRE, "agent");
            asm volatile("s_waitcnt vmcnt(0)" ::: "memory");
        }
    }
    __syncthreads();
}
struct Ctx {
    LAS unsigned char* lds; unsigned char* ws; gu32* ctl; const void* const* in; float* out;
    int tid, lane, wave, vcu, G, gw, NGW;
};
__device__ __forceinline__ void tr_item(const float* W, int K, int N, bf16* WT, int kb, int nb, int orow0, LAS float* scr, int lane) {
    const int k0 = 64 * kb, n0 = 32 * nb;
#pragma unroll 8
    for (int i = 0; i < 32; ++i) { const int kk = 2 * i + (lane >> 5); scr[kk * 33 + (lane & 31)] = W[(size_t)(k0 + kk) * N + n0 + (lane & 31)]; }
    LDS_WAIT(); asm volatile("" ::: "memory");
    const int c = lane & 7;
#pragma unroll
    for (int j = 0; j < 4; ++j) { const int n = (lane >> 3) + 8 * j; const LAS float* s = scr + (8 * c) * 33 + n;
        v4u o; o.x = pk2(s[0 * 33], s[1 * 33]); o.y = pk2(s[2 * 33], s[3 * 33]); o.z = pk2(s[4 * 33], s[5 * 33]); o.w = pk2(s[6 * 33], s[7 * 33]);
        *(GAS v4u*)(WT + (size_t)(orow0 + n) * K + k0 + 8 * c) = o; }
    LDS_WAIT(); asm volatile("" ::: "memory");
}
__device__ __forceinline__ void phase_prologue(const Ctx& C) {
    LAS float* scr = (LAS float*)(C.lds + C.wave * 16384);
    const float* w_in = (const float*)C.in[3]; const float* w_out = (const float*)C.in[14]; const float* w1 = (const float*)C.in[18]; const float* w2 = (const float*)C.in[20];
    bf16* WIN = (bf16*)(C.ws + WS_WIN); bf16* WOUT = (bf16*)(C.ws + WS_WOUT); bf16* W1T = (bf16*)(C.ws + WS_W1); bf16* W2T = (bf16*)(C.ws + WS_W2);
    constexpr int I_IN = 16 * 112, I_OUT = 16 * 32, I_W1 = 32 * 16 * 64, I_W2 = 32 * 16 * 32, NITEMS = I_IN + I_OUT + I_W1 + I_W2;
    for (int it = C.gw; it < NITEMS; it += C.NGW) {
        int r = it;
        if (r < I_IN) { tr_item(w_in, 1024, NPROJ, WIN, r / 112, r % 112, 32 * (r % 112), scr, C.lane); continue; } r -= I_IN;
        if (r < I_OUT) { tr_item(w_out, 1024, 1024, WOUT, r / 32, r % 32, 32 * (r % 32), scr, C.lane); continue; } r -= I_OUT;
        if (r < I_W1) { const int e = r >> 10, rr = r & 1023, kb = rr >> 6, nb = rr & 63, n0 = 32 * nb;
            const int orow0 = (n0 < 1024) ? 256 * (n0 >> 7) + (n0 & 127) : 256 * ((n0 - 1024) >> 7) + 128 + ((n0 - 1024) & 127);
            tr_item(w1 + (size_t)e * 1024 * 2048, 1024, 2048, W1T + (size_t)e * 2048 * 1024, kb, nb, orow0, scr, C.lane); continue; } r -= I_W1;
        { const int e = r >> 9, rr = r & 511, kb = rr >> 5, nb = rr & 31;
            tr_item(w2 + (size_t)e * 1024 * 1024, 1024, 1024, W2T + (size_t)e * 1024 * 1024, kb, nb, 32 * nb, scr, C.lane); }
    }
    const float* x = (const float*)C.in[0]; const float* n1w = (const float*)C.in[2]; bf16* XN = (bf16*)(C.ws + WS_XN);
    f32x4 wv[4];
#pragma unroll
    for (int j = 0; j < 4; ++j) wv[j] = ((const GAS f32x4*)n1w)[C.lane + 64 * j];
    for (int m = C.gw; m < T; m += C.NGW) {
        const GAS f32x4* xr = (const GAS f32x4*)(x + (size_t)m * DM) + C.lane;
        f32x4 v[4]; float s = 0.f;
#pragma unroll
        for (int j = 0; j < 4; ++j) { v[j] = xr[64 * j]; s += (v[j].x * v[j].x + v[j].y * v[j].y) + (v[j].z * v[j].z + v[j].w * v[j].w); }
        const float rstd = rsqrtf(wave_sum(s) * (1.f / DM) + EPS);
        GAS v2u* o8 = (GAS v2u*)(XN + (size_t)m * DM) + C.lane;
#pragma unroll
        for (int j = 0; j < 4; ++j) { const f32x4 y = v[j] * rstd * wv[j]; v2u o; o.x = pk2(y.x, y.y); o.y = pk2(y.z, y.w); o8[64 * j] = o; }
    }
}
__device__ __forceinline__ double dexp_small(double y) {
    const double z = y * (1.0 / 1024.0);
    double r = 1.0 + z * (1.0 + z * (0.5 + z * (1.0 / 6.0 + z * (1.0 / 24.0 + z * (1.0 / 120.0 + z * (1.0 / 720.0))))));
#pragma unroll
    for (int i = 0; i < 10; ++i) r *= r;
    return r;
}
__device__ __forceinline__ void unpack8(const v4u w, float (&f)[8]) {
#pragma unroll
    for (int j = 0; j < 4; ++j) { f[2 * j] = bflo(w[j]); f[2 * j + 1] = bfhi(w[j]); }
}
__device__ __forceinline__ v4u pack8(const float (&f)[8]) { v4u w; w.x = pk2(f[0], f[1]); w.y = pk2(f[2], f[3]); w.z = pk2(f[4], f[5]); w.w = pk2(f[6], f[7]); return w; }
constexpr float QSCALE = 0.125f * 1.4426950408889634f;
__device__ __forceinline__ void phase_qk(const Ctx& C) {
    LAS double* revt = (LAS double*)(C.lds);
    if (C.tid < 72) { const double y = C.tid < 64 ? -((double)C.tid / 63.0) * 9.210340371976184 : -((double)(C.tid - 64) / 8.0) * 13.122363377404328;
        revt[C.tid] = dexp_small(y) * 0.15915494309189535; }
    __syncthreads();
    const int* positions = (const int*)C.in[1]; const float* qnw = (const float*)C.in[7]; const float* knw = (const float*)C.in[8];
    const bf16* PROJ = (const bf16*)(C.ws + WS_PROJ);
    bf16* RQ = (bf16*)(C.ws + WS_RQ); bf16* RK = (bf16*)(C.ws + WS_RK); bf16* DQ = (bf16*)(C.ws + WS_DQ); bf16* DK = (bf16*)(C.ws + WS_DK);
    bf16* RKF = (bf16*)(C.ws + WS_RKF); bf16* RKB = (bf16*)(C.ws + WS_RKB);
    const int L = C.lane;
    const float ldf2 = ((const float*)C.in[4])[L >> 4] * 1.4426950408889634f, ldb2 = ((const float*)C.in[5])[L >> 4] * 1.4426950408889634f;
    float qw[8], kw[8];
#pragma unroll
    for (int e = 0; e < 8; ++e) { qw[e] = qnw[(L & 7) * 8 + e]; kw[e] = knw[(L & 7) * 8 + e]; }
    for (int t = C.gw; t < T; t += C.NGW) {
        const int b = t / SEQ, s = t % SEQ; const double pos = (double)positions[t];
        const bf16* prow = PROJ + (size_t)t * NPROJ;
        {
            float qf[8], kf[8], qo[8], ko[8];
            unpack8(*(const GAS v4u*)(prow + 8 * L), qf); unpack8(*(const GAS v4u*)(prow + 512 + 8 * L), kf);
            const int head = L >> 4, half = (L >> 3) & 1, i0 = (L & 7) * 8;
#pragma unroll
            for (int e = 0; e < 8; ++e) { double a = pos * revt[i0 + e]; a -= rint(a); const float fr = (float)a;
                const float c = __builtin_amdgcn_cosf(fr), sn = __builtin_amdgcn_sinf(fr);
                const float qp = __shfl_xor(qf[e], 8), kp = __shfl_xor(kf[e], 8);
                qo[e] = half ? qf[e] * c + qp * sn : qf[e] * c - qp * sn;
                ko[e] = (half ? kf[e] * c + kp * sn : kf[e] * c - kp * sn) * 0.08838834764831845f; }
            const size_t o = ((size_t)(b * 4 + head) * SEQ + s) * 128 + (L & 15) * 8;
            *(GAS v4u*)(RQ + o) = pack8(qo); *(GAS v4u*)(RK + o) = pack8(ko);
            const float ml = (float)(s & 255), wf = __builtin_amdgcn_exp2f(ldf2 * (255.0f - ml)), wb = __builtin_amdgcn_exp2f(ldb2 * ml);
#pragma unroll
            for (int e = 0; e < 8; ++e) { qo[e] = ko[e] * wf; ko[e] = ko[e] * wb; }
            *(GAS v4u*)(RKF + o) = pack8(qo); *(GAS v4u*)(RKB + o) = pack8(ko);
        }
        {
            float qf[8], kf[8];
            unpack8(*(const GAS v4u*)(prow + 2048 + 8 * L), qf); unpack8(*(const GAS v4u*)(prow + 2560 + 8 * L), kf);
            float sq = 0.f, sk = 0.f;
#pragma unroll
            for (int e = 0; e < 8; ++e) { sq += qf[e] * qf[e]; sk += kf[e] * kf[e]; }
            sq += __shfl_xor(sq, 1); sq += __shfl_xor(sq, 2); sq += __shfl_xor(sq, 4);
            sk += __shfl_xor(sk, 1); sk += __shfl_xor(sk, 2); sk += __shfl_xor(sk, 4);
            const float rq = rsqrtf(sq * (1.f / 64.f) + EPS), rk = rsqrtf(sk * (1.f / 64.f) + EPS);
            const int sel = L & 7;
#pragma unroll
            for (int e = 0; e < 8; ++e) { float y = qf[e] * rq * qw[e], z = kf[e] * rk * kw[e];
                double a = pos * revt[64 + e]; a -= rint(a); const float fr = (float)a;
                const float c = __builtin_amdgcn_cosf(fr), sn = __builtin_amdgcn_sinf(fr);
                const float yp = __shfl_xor(y, 1), zp = __shfl_xor(z, 1);
                if (sel == 0) { y = y * c - yp * sn; z = z * c - zp * sn; }
                else if (sel == 1) { y = y * c + yp * sn; z = z * c + zp * sn; }
                qf[e] = y * QSCALE; kf[e] = z; }
            *(GAS v4u*)(DQ + (size_t)t * 512 + 8 * L) = pack8(qf); *(GAS v4u*)(DK + (size_t)t * 512 + 8 * L) = pack8(kf);
        }
    }
}
__device__ __forceinline__ void phase_mix(const Ctx& C, unsigned char* lds_generic, int part) {
    const float* qnw = (const float*)C.in[7]; const float* knw = (const float*)C.in[8];
    const float s1 = wave_sum(((const float*)C.in[9])[C.lane] * ((const float*)C.in[10])[C.lane]);
    const float s2 = wave_sum(((const float*)C.in[11])[C.lane] * ((const float*)C.in[12])[C.lane]);
    const float mq = wave_max(fabsf(qnw[C.lane])), mk = wave_max(fabsf(knw[C.lane]));
    const float bound = 8.0f * 1.4426950408889634f * mq * mk * 1.001f;
    mix::MixArgs A;
    A.DQ = (const bf16*)(C.ws + WS_DQ); A.DK = (const bf16*)(C.ws + WS_DK); A.RQ = (const bf16*)(C.ws + WS_RQ); A.RK = (const bf16*)(C.ws + WS_RK);
    A.PROJ = (const bf16*)(C.ws + WS_PROJ); A.MIXED = (bf16*)(C.ws + WS_MIXED);
    A.dnw = (const float*)C.in[13]; A.rnw = (const float*)C.in[6];
    A.lam = __int_as_float(__builtin_amdgcn_readfirstlane(__float_as_int(__expf(s1) - __expf(s2) + 0.2f)));
    A.shift = __int_as_float(__builtin_amdgcn_readfirstlane(__float_as_int(bound)));
    A.ldf = (const float*)C.in[4]; A.ldb = (const float*)C.in[5];
    A.RKF = (const bf16*)(C.ws + WS_RKF); A.RKB = (const bf16*)(C.ws + WS_RKB); A.KVT = (float*)(C.ws + WS_KVT); A.ST = (const bf16*)(C.ws + WS_ST);
    if (part == 0) {
        for (int u = C.vcu; u < 512; u += C.G) { const int b = u >> 8, h = (u >> 6) & 3, qb = u & 63; mix::mixer_unit<0>(A, b, h, qb, (char*)lds_generic); }
        for (int u = C.vcu; u < 256; u += C.G) { const int b = u >> 7, h = (u >> 5) & 3, ch = u & 31; mix::kv_unit(A, b, h, ch, (char*)lds_generic); }
    } else {
        for (int u = C.vcu; u < 256; u += C.G) { const int b = u >> 7, h = (u >> 5) & 3, qb = u & 31; mix::mixer_unit<1>(A, b, h, qb, (char*)lds_generic); }
    }
}
__device__ __forceinline__ void phase_scan(const Ctx& C) {
    const float* KVT = (const float*)(C.ws + WS_KVT); bf16* ST = (bf16*)(C.ws + WS_ST);
    for (int gid = C.vcu * (NWAVES * 64) + C.tid; gid < 16 * 4096; gid += C.G * NWAVES * 64) {
        const int bhd = gid >> 12, e4 = gid & 4095, dir = bhd & 1, h = (bhd >> 1) & 3;
        const float ld = dir ? ((const float*)C.in[5])[h] : ((const float*)C.in[4])[h];
        const float g = __builtin_amdgcn_exp2f(ld * 1.4426950408889634f * 256.0f);
        const GAS f32x4* kv = (const GAS f32x4*)(KVT + (size_t)bhd * 32 * 16384) + e4;
        GAS v2u* st = (GAS v2u*)(ST + (size_t)bhd * 32 * 16384) + e4;
        f32x4 S = {0.f, 0.f, 0.f, 0.f};
        f32x4 kvr[32];
#pragma unroll
        for (int i = 0; i < 32; ++i) kvr[i] = kv[(size_t)i * 4096];
        if (dir == 0) {
#pragma unroll
            for (int i = 0; i < 32; ++i) { v2u o; o.x = pk2(S.x, S.y); o.y = pk2(S.z, S.w); st[(size_t)i * 4096] = o; S = S * g + kvr[i]; }
        } else {
#pragma unroll
            for (int i = 31; i >= 0; --i) { v2u o; o.x = pk2(S.x, S.y); o.y = pk2(S.z, S.w); st[(size_t)i * 4096] = o; S = S * g + kvr[i]; }
        }
    }
}
__device__ __forceinline__ void phase_route(const Ctx& C) {
    const float* wr = (const float*)C.in[16]; const float* br = (const float*)C.in[17]; const float* n2w = (const float*)C.in[15];
    LAS float* wl = (LAS float*)C.lds;
    for (int i = C.tid; i < 1024 * 8; i += NWAVES * 64) { const int row = i >> 3, q = i & 7; *(LAS f32x4*)(wl + row * 36 + 4 * q) = ((const GAS f32x4*)wr)[i]; }
    __syncthreads();
    bf16* H2 = (bf16*)(C.ws + WS_H2); int* SEL = (int*)(C.ws + WS_SEL); int* SLOT = (int*)(C.ws + WS_SLOT); float* GATE = (float*)(C.ws + WS_GATE);
    float nw[16];
#pragma unroll
    for (int j = 0; j < 16; ++j) nw[j] = n2w[C.lane + 64 * j];
    LAS int* lcnt = (LAS int*)(C.lds + ROUTE_OFF); LAS int* lbase = lcnt + 32; LAS int* rec = lcnt + 64;
    if (C.tid < 32) lcnt[C.tid] = 0;
    __syncthreads();
    int it_ = 0;
    for (int t = C.gw; t < T; t += C.NGW, ++it_) { const int slot_i = C.wave * 8 + it_;
        const float* xr = (const float*)(C.ws + WS_X1) + (size_t)t * DM;
        float xv[16]; float ss = 0.f;
#pragma unroll
        for (int j = 0; j < 16; ++j) { xv[j] = xr[C.lane + 64 * j]; ss += xv[j] * xv[j]; }
        const float rstd = rsqrtf(wave_sum(ss) * (1.f / DM) + EPS);
        float lg[32];
#pragma unroll
        for (int e = 0; e < 32; ++e) lg[e] = 0.f;
        bf16* hrow = H2 + (size_t)t * DM;
#pragma unroll
        for (int j = 0; j < 16; ++j) { const float h = xv[j] * rstd * nw[j]; hrow[C.lane + 64 * j] = (bf16)(pk2(h, h) & 0xffffu);
            const LAS f32x4* wp = (const LAS f32x4*)(wl + (C.lane + 64 * j) * 36);
#pragma unroll
            for (int q = 0; q < 8; ++q) { const f32x4 w4 = wp[q]; lg[4 * q] += h * w4.x; lg[4 * q + 1] += h * w4.y; lg[4 * q + 2] += h * w4.z; lg[4 * q + 3] += h * w4.w; } }
#pragma unroll
        for (int e = 0; e < 32; ++e) lg[e] = wave_sum(lg[e]) + br[e];
        int idx[4]; float val[4];
#pragma unroll
        for (int k = 0; k < 4; ++k) { float best = -INFINITY; int bi = 0;
#pragma unroll
            for (int e = 0; e < 32; ++e) { if (lg[e] > best) { best = lg[e]; bi = e; } }
#pragma unroll
            for (int e = 0; e < 32; ++e) lg[e] = (e == bi) ? -INFINITY : lg[e];
            idx[k] = bi; val[k] = best; }
        float ex[4], es = 0.f;
#pragma unroll
        for (int k = 0; k < 4; ++k) { ex[k] = __expf(val[k] - val[0]); es += ex[k]; }
        const float ri = 1.0f / es;
        if (C.lane == 0) {
#pragma unroll
            for (int k = 0; k < 4; ++k) { const int rk = __hip_atomic_fetch_add((LAS int*)(lcnt + idx[k]), 1, __ATOMIC_RELAXED, __HIP_MEMORY_SCOPE_WORKGROUP);
                rec[(slot_i * 4 + k) * 2] = (idx[k] << 16) | rk; rec[(slot_i * 4 + k) * 2 + 1] = __float_as_int(ex[k] * ri); } }
    }
    __syncthreads();
    if (C.tid < 32) { const int n = lcnt[C.tid]; lbase[C.tid] = n ? (int)__hip_atomic_fetch_add((unsigned*)(C.ctl + CW_CNT + 64 * C.tid), (unsigned)n, __ATOMIC_RELAXED, __HIP_MEMORY_SCOPE_AGENT) : 0; }
    __syncthreads();
    { int it = 0;
      for (int t = C.gw; t < T; t += C.NGW, ++it) { const int slot_i = C.wave * 8 + it;
        if (C.lane < 4) { const int r0 = rec[(slot_i * 4 + C.lane) * 2], e = r0 >> 16, rk = r0 & 0xffff;
            SEL[t * 4 + C.lane] = e; SLOT[t * 4 + C.lane] = lbase[e] + rk; GATE[t * 4 + C.lane] = __int_as_float(rec[(slot_i * 4 + C.lane) * 2 + 1]); } } }
}
__device__ __forceinline__ void moe_tables(const Ctx& C) {
    LAS int* padoff = (LAS int*)(C.lds + TAB_OFF); LAS unsigned char* tile_e = C.lds + TAB_OFF + 34 * 4;
    LAS int* cnts = (LAS int*)(C.lds + MISC_OFF + 128);
    if (C.tid < 32) cnts[C.tid] = (int)__hip_atomic_load(C.ctl + CW_CNT + 64 * C.tid, RLX_AGENT);
    __syncthreads();
    if (C.tid == 0) { int off = 0, nt = 0;
        for (int e = 0; e < 32; ++e) { const int n = (cnts[e] + 255) >> 8; padoff[e] = off; for (int k = 0; k < n; ++k) tile_e[nt++] = (unsigned char)e; off += n * 256; }
        padoff[32] = off; padoff[33] = nt; }
    __syncthreads();
}
__device__ __forceinline__ void phase_scatter(const Ctx& C) {
    moe_tables(C);
    const LAS int* padoff = (const LAS int*)(C.lds + TAB_OFF);
    const bf16* H2 = (const bf16*)(C.ws + WS_H2); bf16* XG = (bf16*)(C.ws + WS_XG);
    const int* SEL = (const int*)(C.ws + WS_SEL); const int* SLOT = (const int*)(C.ws + WS_SLOT); const float* GATE = (const float*)(C.ws + WS_GATE);
    int* ROWS = (int*)(C.ws + WS_ROWS); float* GATEP = (float*)(C.ws + WS_GATEP);
    for (int t = C.gw; t < T; t += C.NGW) {
        const GAS v4u* hr = (const GAS v4u*)(H2 + (size_t)t * DM);
        const v4u h0 = hr[C.lane], h1 = hr[C.lane + 64];
#pragma unroll
        for (int k = 0; k < 4; ++k) { const int e = SEL[t * 4 + k], sl = SLOT[t * 4 + k]; const int row = padoff[e] + sl;
            GAS v4u* xr = (GAS v4u*)(XG + (size_t)row * DM); xr[C.lane] = h0; xr[C.lane + 64] = h1;
            if (C.lane == 0) { ROWS[t * 4 + k] = row; GATEP[row] = GATE[t * 4 + k]; } }
    }
}
__device__ __forceinline__ void phase_combine(const Ctx& C) {
    const bf16* YB = (const bf16*)(C.ws + WS_XG); const int* ROWS = (const int*)(C.ws + WS_ROWS);
    for (int t = C.gw; t < T; t += C.NGW) {
        int rw[4];
#pragma unroll
        for (int k = 0; k < 4; ++k) rw[k] = ROWS[t * 4 + k];
        GAS f32x4* orow = (GAS f32x4*)(C.out + (size_t)t * DM) + C.lane; const GAS f32x4* xrow = (const GAS f32x4*)((const float*)(C.ws + WS_X1) + (size_t)t * DM) + C.lane;
#pragma unroll
        for (int j = 0; j < 4; ++j) { f32x4 v = xrow[64 * j];
#pragma unroll
            for (int k = 0; k < 4; ++k) { const v2u y = ((const GAS v2u*)(YB + (size_t)rw[k] * DM))[C.lane + 64 * j];
                v.x += bflo(y.x); v.y += bfhi(y.x); v.z += bflo(y.y); v.w += bfhi(y.y); }
            orow[64 * j] = v; }
    }
}
constexpr int N_PHASES = 12;
struct Args { const void* in[22]; float* out; unsigned char* ws; };
template <int LO, int HI>
__global__ void __launch_bounds__(NWAVES * 64, 2) mk_fwd(Args args) {
    extern __shared__ __attribute__((aligned(16))) unsigned char lds[];
    Ctx C;
    C.lds = (LAS unsigned char*)lds; C.ws = args.ws; C.ctl = (gu32*)(args.ws + WS_CTL); C.in = args.in; C.out = args.out;
    C.tid = ltid(); C.lane = C.tid & 63; C.wave = __builtin_amdgcn_readfirstlane((int)threadIdx.x >> 6);
    C.G = gridDim.x; { const int bx = blockIdx.x; C.vcu = (C.G % 8 == 0) ? (bx % 8) * (C.G / 8) + bx / 8 : bx; }
    C.gw = C.vcu * NWAVES + C.wave; C.NGW = C.G * NWAVES;
    volatile LAS unsigned* MISC = (volatile LAS unsigned*)(C.lds + MISC_OFF);
    if (C.tid < 32) MISC[C.tid] = 0u;
    __syncthreads();
    XcdBarrier bar; bar.bar = (unsigned*)(C.ctl + CW_BAR); bar.x = 0; bar.st = nullptr;
    if (HI - LO > 1) bar = xcd_barrier_post((unsigned*)(C.ctl + CW_BAR), MISC + 8);
#define GRID_BAR() xcd_barrier(bar)
#ifdef PH_ONLY
#define IN(k) ((k) == PH_ONLY && LO <= (k) && (k) < HI)
#else
#define IN(k) (LO <= (k) && (k) < HI)
#endif
#define SEAM(k) do { if (IN(k) && IN((k) + 1)) GRID_BAR(); C.tid = ltid(); C.lane = C.tid & 63; } while (0)
    if (IN(0)) { phase_prologue(C); SEAM(0); }
    if (IN(1)) {
        pg8::Gemm g{(const bf16*)(C.ws + WS_XN), (const bf16*)(C.ws + WS_WIN), T, NPROJ, DM}; pg8::StaticOrder S; S.init(T, NPROJ, C.G, (int)blockIdx.x);
        pg8::EpiStoreBf16 E{(bf16*)(C.ws + WS_PROJ), NPROJ};
        pg8::gemm_phase<pg8::EpiStoreBf16, pg8::StaticOrder, true, true>(C.lds + RING_OFF, g, S, E);
        SEAM(1);
    }
    if (IN(2)) { phase_qk(C); SEAM(2); }
    if (IN(3)) { phase_mix(C, lds, 0); SEAM(3); }
    if (IN(4)) { phase_scan(C); SEAM(4); }
    if (IN(5)) { phase_mix(C, lds, 1); SEAM(5); }
    if (IN(6)) {
        pg8::Gemm g{(const bf16*)(C.ws + WS_MIXED), (const bf16*)(C.ws + WS_WOUT), T, DM, DM}; pg8::StaticOrder S; S.init(T, DM, C.G, (int)blockIdx.x);
        pg8::EpiResF32 E{(const float*)C.in[0], (float*)(C.ws + WS_X1), DM};
        pg8::gemm_phase<pg8::EpiResF32, pg8::StaticOrder, true, true>(C.lds + RING_OFF, g, S, E);
        SEAM(6);
    }
    if (IN(7)) { phase_route(C); SEAM(7); }
    if (IN(8)) { phase_scatter(C); SEAM(8); }
    if (IN(9)) {
        moe_tables(C);
        const LAS int* padoff = (const LAS int*)(C.lds + TAB_OFF);
        pg8::Gemm g{(const bf16*)(C.ws + WS_XG), (const bf16*)(C.ws + WS_W1), MAXROWS, NEXP * 2048, DM};
        pg8::MoeOrder S{padoff[33] * 8, 8, C.G, C.vcu, (const LAS unsigned char*)(C.lds + TAB_OFF + 34 * 4)};
        pg8::EpiSwiglu E{(bf16*)(C.ws + WS_ACT), (const float*)C.in[19]};
        pg8::gemm_phase<pg8::EpiSwiglu, pg8::MoeOrder, true, true>(C.lds + RING_OFF, g, S, E);
        SEAM(9);
    }
    if (IN(10)) {
        moe_tables(C);
        const LAS int* padoff = (const LAS int*)(C.lds + TAB_OFF);
        pg8::Gemm g{(const bf16*)(C.ws + WS_ACT), (const bf16*)(C.ws + WS_W2), MAXROWS, NEXP * 1024, DFF};
        pg8::MoeOrder S{padoff[33] * 4, 4, C.G, C.vcu, (const LAS unsigned char*)(C.lds + TAB_OFF + 34 * 4)};
        pg8::EpiGateBf16 E{(bf16*)(C.ws + WS_XG), (const float*)C.in[21], (const float*)(C.ws + WS_GATEP)};
        pg8::gemm_phase<pg8::EpiGateBf16, pg8::MoeOrder, true, true>(C.lds + RING_OFF, g, S, E);
        SEAM(10);
    }
    if (IN(11)) { phase_combine(C); }
#undef IN
#undef SEAM
}

template <int LO, int HI> static void launch_range(int grid, const Args& a, hipStream_t stream) {
    static bool attr_set = false;
    if (!attr_set) { if (hipFuncSetAttribute((const void*)mk_fwd<LO, HI>, hipFuncAttributeMaxDynamicSharedMemorySize, LDS_BYTES) != hipSuccess) fprintf(stderr, "kernel_launch: hipFuncSetAttribute failed\n"); attr_set = true; }
    hipLaunchKernelGGL((mk_fwd<LO, HI>), dim3(grid), dim3(NWAVES * 64), LDS_BYTES, stream, a);
}
extern "C" void kernel_launch(void* const* d_in, const int* in_sizes, int n_in, void* d_out, int out_size, void* d_ws, size_t ws_size, hipStream_t stream) {
    static int grid = 0;
    if (grid == 0) {
        if (n_in != 22 || in_sizes[0] != T * DM || out_size != T * DM || ws_size < WS_END) {
            fprintf(stderr, "kernel_launch: shape mismatch (n_in %d, in0 %d, out %d, ws %zu; need ws >= %zu); nothing launched\n", n_in, n_in > 0 ? in_sizes[0] : -1, out_size, ws_size, (size_t)WS_END); grid = -1; return; }
        int dev = 0, cus = 0;
        if (hipGetDevice(&dev) != hipSuccess || hipDeviceGetAttribute(&cus, hipDeviceAttributeMultiprocessorCount, dev) != hipSuccess) { fprintf(stderr, "kernel_launch: device query failed\n"); grid = -1; return; }
        if (cus < 256) { fprintf(stderr, "kernel_launch: built for a 256-CU device (found %d CUs); nothing launched\n", cus); grid = -1; return; }
        grid = 256;
    }
    if (grid < 0) return;
    if (hipMemsetAsync((char*)d_ws + WS_CTL, 0, CTL_ZERO_BYTES, stream) != hipSuccess) { fprintf(stderr, "kernel_launch: memset failed\n"); return; }
    Args a{};
    for (int i = 0; i < 22; ++i) a.in[i] = d_in[i];
    a.out = (float*)d_out; a.ws = (unsigned char*)d_ws;
#if MK_SPLIT
#ifndef DUP_MASK
#define DUP_MASK 0
#endif
#define LP(k) do { launch_range<(k), (k) + 1>(grid, a, stream); if ((DUP_MASK >> (k)) & 1) launch_range<(k), (k) + 1>(grid, a, stream); } while (0)
    LP(0); LP(1); LP(2); LP(3); LP(4); LP(5); LP(6); LP(7);
    if ((DUP_MASK >> 12) & 1) { (void)hipMemsetAsync((char*)d_ws + WS_CTL, 0, CTL_ZERO_BYTES, stream); launch_range<7, 8>(grid, a, stream); }
    LP(8); LP(9); LP(10); LP(11);
#else
    launch_range<0, N_PHASES>(grid, a, stream);
#endif
    const hipError_t le = hipPeekAtLastError();
    if (le != hipSuccess) fprintf(stderr, "kernel_launch: launch failed: %s\n", hipGetErrorName(le));
}
```

```cpp
#include <hip/hip_runtime.h>
#include <hip/hip_bf16.h>
#include <cstdio>
#include <cstdint>
#include <cmath>
#ifndef MK_SPLIT
#define MK_SPLIT 0
#endif
__device__ __forceinline__ int ltid() { int t = (int)threadIdx.x; asm volatile("" : "+v"(t)); return t; }
namespace pg8 {
#define PG8_LAS __attribute__((address_space(3)))
typedef unsigned short bf16_t;
typedef short bf16x8 __attribute__((ext_vector_type(8)));
typedef float f32x4 __attribute__((ext_vector_type(4)));
typedef unsigned u32x4 __attribute__((ext_vector_type(4)));
constexpr int BM = 256, BK = 64, HALF = 128, HTB = HALF * BK * 2  , STAGE_BYTES = 8 * HTB, NXCD = 8, WGM = 8;

__host__ __device__ __forceinline__ int lds_byte(int r, int c) { const int st = (r >> 4) * 2 + (c >> 5), rr = r & 15, cc = c & 31, ob = rr * 64 + cc * 2; return st * 1024 + (ob ^ (((ob >> 9) & 1) << 5)); }
__host__ __device__ __forceinline__ void stage_rc(int b, int& R, int& C) { const int st = b / 1024, sb = b % 1024, swz = sb ^ (((sb >> 9) & 1) << 5); R = (st >> 1) * 16 + swz / 64; C = (st & 1) * 32 + (swz % 64) / 2; }
__host__ __device__ __forceinline__ int perm32(int rho) { const int n = rho >> 4, i = rho & 15; return 8 * (i >> 2) + 4 * n + (i & 3); }

struct Unit { int pm, pn; };
struct Gemm { const bf16_t* A; const bf16_t* Bt; int M, N, K; };

struct StaticOrder {
    static constexpr bool GATHER = false;
    int nM, nN, nwg, G, c;
    __host__ __device__ void init(int M, int N, int G_, int c_) { nM = M / BM; nN = N / BM; nwg = nM * nN; G = G_; c = c_; }
    __host__ __device__ bool next(int i, Unit& u) const {
        const long L = (long)i * G + c; if (L >= nwg) return false;
        int wgid = (int)L; { const int q = nwg / NXCD, r = nwg % NXCD, xcd = wgid % NXCD, off = wgid / NXCD; wgid = (xcd < r ? xcd * (q + 1) : r * (q + 1) + (xcd - r) * q) + off; }
        const int nig = WGM * nN, gid = wgid / nig, fm = gid * WGM, gsz = (nM - fm) < WGM ? (nM - fm) : WGM;
        u.pm = fm + ((wgid % nig) % gsz); u.pn = (wgid % nig) / gsz; return true;
    }
    __device__ __forceinline__ void a_ready(const Unit&) const {}
    __device__ __forceinline__ void done(const Unit&) const {}
};

__device__ __forceinline__ unsigned cvt_pk_bf16(float lo, float hi) { unsigned r; asm volatile("v_cvt_pk_bf16_f32 %0, %1, %2" : "=v"(r) : "v"(lo), "v"(hi)); return r; }
typedef float f32x2 __attribute__((ext_vector_type(2)));
struct EpiStoreBf16 {
    static constexpr bool PERM = true, AFTER_DRAIN = false;
    bf16_t* O; int ldc;
    __device__ __forceinline__ void operator()(const f32x4 (&acc)[2][2][4][2], const Unit& u, int wr, int wc, int fr, int fq) const {
        const int row0 = u.pm * BM + wr * 64 + fr, col0 = u.pn * BM + wc * 32 + 8 * fq;
#pragma unroll
        for (int ai = 0; ai < 2; ++ai)
#pragma unroll
            for (int m = 0; m < 4; ++m) { bf16_t* rowp = O + (size_t)(row0 + ai * HALF + m * 16) * ldc + col0;
#pragma unroll
                for (int bj = 0; bj < 2; ++bj) { const f32x4 v0 = acc[ai][bj][m][0], v1 = acc[ai][bj][m][1];
                    u32x4 w; w.x = cvt_pk_bf16(v0[0], v0[1]); w.y = cvt_pk_bf16(v0[2], v0[3]); w.z = cvt_pk_bf16(v1[0], v1[1]); w.w = cvt_pk_bf16(v1[2], v1[3]);
                    *(u32x4*)(rowp + bj * HALF) = w; } }
    }
};
struct EpiResF32 {
    static constexpr bool PERM = false, AFTER_DRAIN = false;
    const float* base; float* out; int ldc;
    __device__ __forceinline__ void operator()(const f32x4 (&acc)[2][2][4][2], const Unit& u, int wr, int wc, int fr, int fq) const {
        const int row0 = u.pm * BM + wr * 64 + fr, col0 = u.pn * BM + wc * 32 + 4 * fq;
#pragma unroll
        for (int ai = 0; ai < 2; ++ai)
#pragma unroll
            for (int m = 0; m < 4; ++m) { const size_t off = (size_t)(row0 + ai * HALF + m * 16) * ldc + col0;
#pragma unroll
                for (int bj = 0; bj < 2; ++bj)
#pragma unroll
                    for (int n = 0; n < 2; ++n) { const f32x4 bs = *(const f32x4*)(base + off + bj * HALF + n * 16); *(f32x4*)(out + off + bj * HALF + n * 16) = bs + acc[ai][bj][m][n]; } }
    }
};
struct EpiSwiglu {
    static constexpr bool PERM = true, AFTER_DRAIN = false;
    bf16_t* ACT; const float* b1;
    __device__ __forceinline__ void operator()(const f32x4 (&acc)[2][2][4][2], const Unit& u, int wr, int wc, int fr, int fq) const {
        const int e = u.pn >> 3, pnl = u.pn & 7, colact0 = pnl * 128 + wc * 32 + 8 * fq;
        const int row0 = u.pm * BM + wr * 64 + fr;
        f32x4 bg[2], bl[2];
#pragma unroll
        for (int n = 0; n < 2; ++n) { bg[n] = *(const f32x4*)(b1 + (size_t)e * 2048 + colact0 + 4 * n); bl[n] = *(const f32x4*)(b1 + (size_t)e * 2048 + 1024 + colact0 + 4 * n); }
#pragma unroll
        for (int ai = 0; ai < 2; ++ai)
#pragma unroll
            for (int m = 0; m < 4; ++m) { float a[8];
#pragma unroll
                for (int n = 0; n < 2; ++n) { const f32x4 g4 = acc[ai][0][m][n] + bg[n], l4 = acc[ai][1][m][n] + bl[n];
#pragma unroll
                    for (int i = 0; i < 4; ++i) { const float g = fminf(g4[i], 7.0f), l = fminf(fmaxf(l4[i], -7.0f), 7.0f);
                        const float sg = __builtin_amdgcn_rcpf(1.0f + __builtin_amdgcn_exp2f(-1.702f * 1.4426950408889634f * g));
                        a[4 * n + i] = g * sg * (l + 1.0f); } }
                u32x4 w; w.x = cvt_pk_bf16(a[0], a[1]); w.y = cvt_pk_bf16(a[2], a[3]); w.z = cvt_pk_bf16(a[4], a[5]); w.w = cvt_pk_bf16(a[6], a[7]);
                *(u32x4*)(ACT + (size_t)(row0 + ai * HALF + m * 16) * 1024 + colact0) = w; }
    }
};
struct EpiGateBf16 {
    static constexpr bool PERM = true, AFTER_DRAIN = false;
    bf16_t* Y; const float* b2; const float* gatee; const PG8_LAS int* padoff; const PG8_LAS int* cnts;
    __device__ __forceinline__ void operator()(const f32x4 (&acc)[2][2][4][2], const Unit& u, int wr, int wc, int fr, int fq) const {
        const int e = u.pn >> 2, pnl = u.pn & 3, col0 = pnl * BM + wc * 32 + 8 * fq;
        const int row0 = u.pm * BM + wr * 64 + fr;
        f32x4 bv[2][2];
#pragma unroll
        for (int bj = 0; bj < 2; ++bj)
#pragma unroll
            for (int n = 0; n < 2; ++n) bv[bj][n] = *(const f32x4*)(b2 + (size_t)e * 1024 + col0 + bj * HALF + 4 * n);
#pragma unroll
        for (int ai = 0; ai < 2; ++ai)
#pragma unroll
            for (int m = 0; m < 4; ++m) { const int row = row0 + ai * HALF + m * 16; const int slot = row - padoff[e]; const float g = slot < cnts[e] ? gatee[e * 16384 + slot] : 0.f;
#pragma unroll
                for (int bj = 0; bj < 2; ++bj) { const f32x4 v0 = (acc[ai][bj][m][0] + bv[bj][0]) * g, v1 = (acc[ai][bj][m][1] + bv[bj][1]) * g;
                    u32x4 w; w.x = cvt_pk_bf16(v0[0], v0[1]); w.y = cvt_pk_bf16(v0[2], v0[3]); w.z = cvt_pk_bf16(v1[0], v1[1]); w.w = cvt_pk_bf16(v1[2], v1[3]);
                    *(u32x4*)(Y + (size_t)row * 1024 + col0 + bj * HALF) = w; } }
    }
};
struct MoeOrder {
    static constexpr bool GATHER = false;
    int nunits, npn, G, c; const PG8_LAS unsigned char* tile_e;
    __device__ __forceinline__ bool next(int i, Unit& u) const {
        const long L = (long)i * G + c; if (L >= nunits) return false;
        const int tm = (int)L / npn, j = (int)L % npn; u.pm = tm; u.pn = (int)tile_e[tm] * npn + j; return true;
    }
    __device__ __forceinline__ void a_ready(const Unit&) const {}
    __device__ __forceinline__ void done(const Unit&) const {}
};
struct MoeGatherOrder {
    static constexpr bool GATHER = true;
    int nunits, npn, G, c; const PG8_LAS unsigned char* tile_e; const PG8_LAS int* padoff; const PG8_LAS int* cnts; const int* toke; int rowbytes;
    __device__ __forceinline__ bool next(int i, Unit& u) const {
        const long L = (long)i * G + c; if (L >= nunits) return false;
        const int tm = (int)L / npn, j = (int)L % npn; u.pm = tm; u.pn = (int)tile_e[tm] * npn + j; return true;
    }
    __device__ __forceinline__ unsigned arow(const Unit& u, int r) const {
        const int e = (int)tile_e[u.pm], slot = u.pm * 256 - padoff[e] + r;
        const int tok = slot < cnts[e] ? toke[e * 16384 + slot] : 0;
        return (unsigned)tok * (unsigned)rowbytes;
    }
    __device__ __forceinline__ void a_ready(const Unit&) const {}
    __device__ __forceinline__ void done(const Unit&) const {}
};
template <class Epi, class Sched, bool ALIGN_EPI = false, bool SP2 = false>
__device__ __forceinline__ void gemm_phase(PG8_LAS unsigned char* lds, const Gemm g, const Sched& S, const Epi& E) {
    const int tid = ltid(), wid = __builtin_amdgcn_readfirstlane(tid >> 6), lane = tid & 63, wr = wid >> 2, wc = wid & 3, fr = lane & 15, fq = lane >> 4;
    const int K = g.K, nt = K / BK;
    unsigned voffA[2], voffB[2]; int rA[2]; unsigned cA2[2];
#pragma unroll
    for (int i = 0; i < 2; ++i) { int R, C; stage_rc(tid * 16 + i * 8192, R, C); const int Rb = Epi::PERM ? ((R & ~31) + perm32(R & 31)) : R;
        voffA[i] = (unsigned)(R * K + C) * 2u; voffB[i] = (unsigned)(Rb * K + C) * 2u; rA[i] = R; cA2[i] = (unsigned)C * 2u; }
#define PG8_AOFFS(u, o0, o1) do { _Pragma("unroll") for (int _i = 0; _i < 2; ++_i) { \
        if constexpr (Sched::GATHER) { o0[_i] = S.arow(u, rA[_i]) + cA2[_i]; o1[_i] = S.arow(u, rA[_i] + HALF) + cA2[_i]; } \
        else { o0[_i] = voffA[_i]; o1[_i] = voffA[_i] + (unsigned)(HALF * K * 2); } } } while (0)
    const size_t kstep = (size_t)(BK * 2);
    const size_t hstep = (size_t)HALF * K * 2;
    const size_t tstep = 2 * hstep;
    const unsigned ldsw = (unsigned)wid * 1024u;
    const int aoff = lds_byte(wr * 64 + fr, fq * 8), boff = lds_byte(wc * 32 + fr, fq * 8);
#define PG8_SA(b, h) (((b) * 2 + (h)) * HTB)
#define PG8_SB(b, h) ((4 + (b) * 2 + (h)) * HTB)
#define PG8_STAGE(bufoff, gbase, voff) do { _Pragma("unroll") for (int _i = 0; _i < 2; ++_i) \
        __builtin_amdgcn_global_load_lds((const unsigned*)((const char*)(gbase) + (voff)[_i]), (PG8_LAS unsigned*)(lds + (bufoff) + ldsw + _i * 8192), 16, 0, 0); } while (0)
#define PG8_LDA(dst, b, h) do { _Pragma("unroll") for (int m = 0; m < 4; ++m) _Pragma("unroll") for (int k = 0; k < 2; ++k) dst[m][k] = *(const PG8_LAS bf16x8*)(lds + PG8_SA(b, h) + aoff + m * 2048 + k * 1024); } while (0)
#define PG8_LDB(dst, b, h) do { _Pragma("unroll") for (int n = 0; n < 2; ++n) _Pragma("unroll") for (int k = 0; k < 2; ++k) dst[n][k] = *(const PG8_LAS bf16x8*)(lds + PG8_SB(b, h) + boff + n * 2048 + k * 1024); } while (0)
#define PG8_MMA(ai, bj, At, Bt) do { __builtin_amdgcn_s_setprio(1); _Pragma("unroll") for (int m = 0; m < 4; ++m) _Pragma("unroll") for (int n = 0; n < 2; ++n) _Pragma("unroll") for (int k = 0; k < 2; ++k) \
        acc[ai][bj][m][n] = __builtin_amdgcn_mfma_f32_16x16x32_bf16(Bt[n][k], At[m][k], acc[ai][bj][m][n], 0, 0, 0); __builtin_amdgcn_s_setprio(0); } while (0)
#define PG8_WAIT_V(n) asm volatile("s_waitcnt vmcnt(" #n ")" ::: "memory")
#define PG8_WAIT_L(n) asm volatile("s_waitcnt lgkmcnt(" #n ")" ::: "memory")
#define PG8_BAR __builtin_amdgcn_s_barrier()
#define PG8_SCHED __builtin_amdgcn_sched_barrier(0)
    Unit cur, nxt; int ui = 0;
    if (!S.next(0, cur)) return;
    f32x4 acc[2][2][4][2];
#pragma unroll
    for (int a = 0; a < 2; ++a)
#pragma unroll
        for (int b = 0; b < 2; ++b)
#pragma unroll
            for (int m = 0; m < 4; ++m)
#pragma unroll
                for (int n = 0; n < 2; ++n) acc[a][b][m][n] = (f32x4){0.f, 0.f, 0.f, 0.f};
    bf16x8 At[4][2], B0[2][2], B1[2][2];
    const char* cA = (const char*)g.A + (Sched::GATHER ? (size_t)0 : (size_t)cur.pm * tstep); const char* cB = (const char*)g.Bt + (size_t)cur.pn * tstep;
    unsigned va0[2], va1[2], na0[2], na1[2];
    PG8_AOFFS(cur, va0, va1);
    if constexpr (Sched::GATHER) { asm volatile("s_waitcnt vmcnt(0)" ::: "memory"); asm volatile("" : "+v"(va0[0]), "+v"(va0[1]), "+v"(va1[0]), "+v"(va1[1])); }
    S.a_ready(cur);
    if constexpr (SP2) {
        PG8_STAGE(PG8_SB(0, 0), cB, voffB); PG8_STAGE(PG8_SB(0, 1), cB + hstep, voffB); PG8_STAGE(PG8_SA(0, 0), cA, va0); PG8_STAGE(PG8_SA(0, 1), cA, va1);
        if (wr == 1) PG8_BAR;
        PG8_WAIT_V(2); PG8_BAR;
        PG8_STAGE(PG8_SB(1, 0), cB + kstep, voffB); PG8_STAGE(PG8_SA(1, 0), cA + kstep, va0); PG8_STAGE(PG8_SB(1, 1), cB + hstep + kstep, voffB);
        PG8_WAIT_V(6); PG8_BAR;
    } else {
        PG8_STAGE(PG8_SB(0, 0), cB, voffB); PG8_STAGE(PG8_SA(0, 0), cA, va0); PG8_STAGE(PG8_SB(0, 1), cB + hstep, voffB); PG8_STAGE(PG8_SA(0, 1), cA, va1);
        if (wr == 1) PG8_BAR;
        PG8_WAIT_V(4); PG8_BAR;
        PG8_STAGE(PG8_SB(1, 0), cB + kstep, voffB); PG8_STAGE(PG8_SA(1, 0), cA + kstep, va0); PG8_STAGE(PG8_SB(1, 1), cB + hstep + kstep, voffB);
        PG8_WAIT_V(6); PG8_BAR;
    }
    for (;;) {
        const bool has_next = S.next(ui + 1, nxt);
        const char* nA = (has_next && !Sched::GATHER) ? (const char*)g.A + (size_t)nxt.pm * tstep : cA; const char* nB = has_next ? (const char*)g.Bt + (size_t)nxt.pn * tstep : cB;
        if (has_next) { PG8_AOFFS(nxt, na0, na1); } else { na0[0] = va0[0]; na0[1] = va0[1]; na1[0] = va1[0]; na1[1] = va1[1]; }
        if constexpr (Sched::GATHER) { asm volatile("s_waitcnt vmcnt(0)" ::: "memory"); asm volatile("" : "+v"(na0[0]), "+v"(na0[1]), "+v"(na1[0]), "+v"(na1[1])); }
        for (int t = 0; t < nt; t += 2) {
            const bool last = (t == nt - 2);
            const char* a1 = cA + (size_t)(t + 1) * kstep;
            const char* a2 = last ? nA : cA + (size_t)(t + 2) * kstep; const char* b2 = last ? nB : cB + (size_t)(t + 2) * kstep;
            const char* a3 = a2 + kstep; const char* b3 = b2 + kstep;
            unsigned x0[2], x1[2];
            x0[0] = last ? na0[0] : va0[0]; x0[1] = last ? na0[1] : va0[1]; x1[0] = last ? na1[0] : va1[0]; x1[1] = last ? na1[1] : va1[1];
            if (last && has_next) S.a_ready(nxt);
            if constexpr (SP2) {
            PG8_LDB(B0, 0, 0); PG8_LDB(B1, 0, 1); PG8_SCHED; PG8_LDA(At, 0, 0); PG8_STAGE(PG8_SA(1, 1), a1, va1);
            PG8_WAIT_V(8); PG8_WAIT_L(0); PG8_BAR; PG8_MMA(0, 0, At, B0); PG8_MMA(0, 1, At, B1); PG8_BAR; PG8_SCHED;
            PG8_LDA(At, 0, 1); PG8_STAGE(PG8_SB(0, 0), b2, voffB); PG8_STAGE(PG8_SB(0, 1), b2 + hstep, voffB); PG8_STAGE(PG8_SA(0, 0), a2, x0);
            PG8_WAIT_V(8); PG8_WAIT_L(0); PG8_BAR; PG8_MMA(1, 0, At, B0); PG8_MMA(1, 1, At, B1); PG8_BAR; PG8_SCHED;
            PG8_LDB(B0, 1, 0); PG8_LDB(B1, 1, 1); PG8_SCHED; PG8_LDA(At, 1, 0); PG8_STAGE(PG8_SA(0, 1), a2, x1);
            PG8_WAIT_V(8); PG8_WAIT_L(0); PG8_BAR; PG8_MMA(0, 0, At, B0); PG8_MMA(0, 1, At, B1); PG8_BAR; PG8_SCHED;
            PG8_LDA(At, 1, 1); PG8_STAGE(PG8_SB(1, 0), b3, voffB); PG8_STAGE(PG8_SB(1, 1), b3 + hstep, voffB); PG8_STAGE(PG8_SA(1, 0), a3, x0);
            PG8_WAIT_V(8); PG8_WAIT_L(0); PG8_BAR; PG8_MMA(1, 0, At, B0); PG8_MMA(1, 1, At, B1); PG8_BAR; PG8_SCHED;
            } else {
            PG8_LDB(B0, 0, 0); PG8_SCHED; PG8_LDA(At, 0, 0); PG8_STAGE(PG8_SA(1, 1), a1, va1);
            PG8_WAIT_L(8); PG8_BAR; PG8_WAIT_L(0); PG8_MMA(0, 0, At, B0); PG8_BAR; PG8_SCHED;
            PG8_LDB(B1, 0, 1); PG8_STAGE(PG8_SB(0, 0), b2, voffB);
            PG8_BAR; PG8_WAIT_L(0); PG8_MMA(0, 1, At, B1); PG8_BAR;
            PG8_LDA(At, 0, 1); PG8_STAGE(PG8_SA(0, 0), a2, x0);
            PG8_BAR; PG8_WAIT_L(0); PG8_MMA(1, 0, At, B0); PG8_BAR; PG8_SCHED;
            PG8_STAGE(PG8_SB(0, 1), b2 + hstep, voffB);
            PG8_WAIT_V(6); PG8_BAR; PG8_MMA(1, 1, At, B1); PG8_BAR;
            PG8_LDB(B0, 1, 0); PG8_SCHED; PG8_LDA(At, 1, 0); PG8_STAGE(PG8_SA(0, 1), a2, x1);
            PG8_WAIT_L(8); PG8_BAR; PG8_WAIT_L(0); PG8_MMA(0, 0, At, B0); PG8_BAR; PG8_SCHED;
            PG8_LDB(B1, 1, 1); PG8_STAGE(PG8_SB(1, 0), b3, voffB);
            PG8_BAR; PG8_WAIT_L(0); PG8_MMA(0, 1, At, B1); PG8_BAR;
            PG8_LDA(At, 1, 1); PG8_STAGE(PG8_SA(1, 0), a3, x0);
            PG8_BAR; PG8_WAIT_L(0); PG8_MMA(1, 0, At, B0); PG8_BAR; PG8_SCHED;
            PG8_STAGE(PG8_SB(1, 1), b3 + hstep, voffB);
            PG8_WAIT_V(6); PG8_BAR; PG8_MMA(1, 1, At, B1); PG8_BAR;
            }
        }
        if constexpr (ALIGN_EPI) { if (wr == 0) PG8_BAR; }
        if constexpr (!Epi::AFTER_DRAIN) { E(acc, cur, wr, wc, fr, fq); S.done(cur); }
        if (!has_next) break;
#pragma unroll
        for (int a = 0; a < 2; ++a)
#pragma unroll
            for (int b = 0; b < 2; ++b)
#pragma unroll
                for (int m = 0; m < 4; ++m)
#pragma unroll
                    for (int n = 0; n < 2; ++n) acc[a][b][m][n] = (f32x4){0.f, 0.f, 0.f, 0.f};
        cur = nxt; cA = nA; cB = nB; ++ui; va0[0] = na0[0]; va0[1] = na0[1]; va1[0] = na1[0]; va1[1] = na1[1];
        if constexpr (ALIGN_EPI) { if (wr == 1) PG8_BAR; }
    }
    PG8_WAIT_V(0);
    if constexpr (!ALIGN_EPI) { if (wr == 0) PG8_BAR; }
    PG8_BAR;
    if constexpr (Epi::AFTER_DRAIN) { E.fused(acc, cur, wr, wc, fr, fq, lds, wid, lane); S.done(cur); }
#undef PG8_AOFFS
#undef PG8_SA
#undef PG8_SB
#undef PG8_STAGE
#undef PG8_LDA
#undef PG8_LDB
#undef PG8_MMA
#undef PG8_WAIT_V
#undef PG8_WAIT_L
#undef PG8_BAR
#undef PG8_SCHED
}
}
namespace mix {
using bf16 = unsigned short;
using bf16x8 = __attribute__((ext_vector_type(8))) short;
using s16x4  = __attribute__((ext_vector_type(4))) short;
using f32x16 = __attribute__((ext_vector_type(16))) float;
using u32x4  = __attribute__((ext_vector_type(4))) unsigned;
constexpr int NW = 8, QBLK = 32, KVBLK = 64, SEQ = 8192;
constexpr int SHM_V = KVBLK * 128 * 2, SHM_K = KVBLK * 128 * 2, MIX_LDS = 2 * SHM_V + 2 * SHM_K + NW * 64 * 4;
#define KSWZ(row, colB) ((row) * 256 + ((colB) ^ (((row) & 7) << 4)))
#define SBAR() __builtin_amdgcn_sched_barrier(0)
__device__ __forceinline__ int crow(int r, int hi) { return (r & 3) + 8 * (r >> 2) + 4 * hi; }
__device__ __forceinline__ unsigned cvtpk(float lo, float hi) { unsigned r; asm volatile("v_cvt_pk_bf16_f32 %0, %1, %2" : "=v"(r) : "v"(lo), "v"(hi)); return r; }
__device__ __forceinline__ float bf2f(unsigned short b) { return __uint_as_float((unsigned)b << 16); }
__device__ __forceinline__ unsigned short f2bf(float f) { return (unsigned short)(cvtpk(f, f) & 0xffffu); }
__device__ __forceinline__ int v_st(int k, int c) { const int kk = (k & ~0xC) | ((k & 4) << 1) | ((k & 8) >> 1); return ((kk >> 3) * 4 + (c >> 5)) * 512 + ((kk & 7) * 32 + (c & 31)) * 2; }
__device__ __forceinline__ int v_rd_base(int lane) { return ((lane & 3) << 3) | (((lane >> 2) & 3) << 6) | (((lane >> 4) & 1) << 5) | (((lane >> 5) & 1) << 8); }
constexpr int v_rd_off(int d0, int ks, int half) { return d0 * 512 + ks * 4096 + half * 2048; }
template <int OFF> __device__ __forceinline__ s16x4 tr_read(int vb) {
  s16x4 r; asm volatile("ds_read_b64_tr_b16 %0, %1 offset:%2" : "=&v"(r) : "v"(vb), "i"(OFF) : "memory"); return r;
}
template <int D0> __device__ __forceinline__ void pv_one(f32x16& od, int vb, bf16x8 pa0, bf16x8 pa1, bf16x8 pa2, bf16x8 pa3) {
  const s16x4 l0 = tr_read<v_rd_off(D0, 0, 0)>(vb), h0 = tr_read<v_rd_off(D0, 0, 1)>(vb), l1 = tr_read<v_rd_off(D0, 1, 0)>(vb), h1 = tr_read<v_rd_off(D0, 1, 1)>(vb);
  const s16x4 l2 = tr_read<v_rd_off(D0, 2, 0)>(vb), h2 = tr_read<v_rd_off(D0, 2, 1)>(vb), l3 = tr_read<v_rd_off(D0, 3, 0)>(vb), h3 = tr_read<v_rd_off(D0, 3, 1)>(vb);
  asm volatile("s_waitcnt lgkmcnt(0)" ::: "memory"); SBAR();
#define PK(L, H) (bf16x8){L[0], L[1], L[2], L[3], H[0], H[1], H[2], H[3]}
  od = __builtin_amdgcn_mfma_f32_32x32x16_bf16(pa0, PK(l0, h0), od, 0, 0, 0);
  od = __builtin_amdgcn_mfma_f32_32x32x16_bf16(pa1, PK(l1, h1), od, 0, 0, 0);
  od = __builtin_amdgcn_mfma_f32_32x32x16_bf16(pa2, PK(l2, h2), od, 0, 0, 0);
  od = __builtin_amdgcn_mfma_f32_32x32x16_bf16(pa3, PK(l3, h3), od, 0, 0, 0);
#undef PK
}
__device__ __forceinline__ void pv_d0(f32x16* o, int vb, bf16x8 pa0, bf16x8 pa1, bf16x8 pa2, bf16x8 pa3) {
  pv_one<0>(o[0], vb, pa0, pa1, pa2, pa3); pv_one<1>(o[1], vb, pa0, pa1, pa2, pa3); pv_one<2>(o[2], vb, pa0, pa1, pa2, pa3); pv_one<3>(o[3], vb, pa0, pa1, pa2, pa3);
}
template <int ND> __device__ __forceinline__ void qkt(f32x16& p0, f32x16& p1, const char* Ks, const bf16x8* qr, int r32, int hi, int dbase, const f32x16& cinit) {
  p0 = cinit; p1 = cinit;
#pragma unroll
  for (int d0 = 0; d0 < ND; ++d0) { const int cb = ((dbase + d0) * 16 + hi * 8) * 2;
    const bf16x8 b0 = *reinterpret_cast<const bf16x8*>(Ks + KSWZ(r32, cb));
    const bf16x8 b1 = *reinterpret_cast<const bf16x8*>(Ks + KSWZ(32 + r32, cb));
    p0 = __builtin_amdgcn_mfma_f32_32x32x16_bf16(b0, qr[d0], p0, 0, 0, 0);
    p1 = __builtin_amdgcn_mfma_f32_32x32x16_bf16(b1, qr[d0], p1, 0, 0, 0); }
}
__device__ __forceinline__ void packP(const f32x16& p0, const f32x16& p1, bf16x8& pa0, bf16x8& pa1, bf16x8& pa2, bf16x8& pa3) {
#define PK4(P, BASE, OUT) do { unsigned a0 = cvtpk(P[BASE + 0], P[BASE + 1]), a1 = cvtpk(P[BASE + 2], P[BASE + 3]);   \
    unsigned b0 = cvtpk(P[BASE + 4], P[BASE + 5]), b1 = cvtpk(P[BASE + 6], P[BASE + 7]);                              \
    auto r0 = __builtin_amdgcn_permlane32_swap(a0, b0, false, false); auto r1 = __builtin_amdgcn_permlane32_swap(a1, b1, false, false); \
    u32x4 w = {r0[0], r1[0], r0[1], r1[1]}; OUT = *reinterpret_cast<bf16x8*>(&w); } while (0)
  PK4(p0, 0, pa0); PK4(p0, 8, pa1); PK4(p1, 0, pa2); PK4(p1, 8, pa3);
#undef PK4
}
struct MixArgs {
  const bf16* DQ; const bf16* DK; const bf16* RQ; const bf16* RK; const bf16* PROJ; bf16* MIXED;
  const bf16* RKF; const bf16* RKB; float* KVT; const bf16* ST;
  const float* dnw;
  const float* rnw;
  float lam;
  float shift;
  const float* ldf; const float* ldb;
};
template <int MODE>
__device__ __forceinline__ void mixer_unit(const MixArgs& A, int b, int h, int qb, char* lds) {
  const int tid = ltid(), wid = __builtin_amdgcn_readfirstlane(tid >> 6), lane = tid & 63, r32 = lane & 31, hi = lane >> 5;
  char* V_lds = lds; char* K_lds = lds + 2 * SHM_V;
  float* ws = (float*)(lds + 2 * SHM_V + 2 * SHM_K) + wid * 64;
  constexpr int ND = MODE == 0 ? 4 : 8;
  const int c = MODE == 0 ? (wid >> 2) : 0, wq = MODE == 0 ? (wid & 3) : wid;
  const int q0 = qb * (MODE == 0 ? 128 : 256);
  const long tok0 = (long)b * SEQ;
  const bf16* Qw; const bf16* Kh; const bf16* Vh; int LDK;
  if (MODE == 0) { Qw = A.DQ + (tok0 + q0 + wq * QBLK + r32) * 512 + h * 128 + c * 64 + hi * 8; Kh = A.DK + tok0 * 512 + h * 128; LDK = 512; Vh = A.PROJ + tok0 * 3584 + 3072 + h * 128; }
  else           { Qw = A.RQ + ((long)(b * 4 + h) * SEQ + q0 + wq * QBLK + r32) * 128 + hi * 8; Kh = A.RK + (long)(b * 4 + h) * SEQ * 128; LDK = 128; Vh = A.PROJ + tok0 * 3584 + 1024 + h * 128; }
  constexpr int LDV = 3584;
  bf16x8 qr[ND];
#pragma unroll
  for (int d0 = 0; d0 < ND; ++d0) qr[d0] = *reinterpret_cast<const bf16x8*>(Qw + d0 * 16);
  const int sr = tid >> 4, sc = (tid & 15) * 8, vst0 = v_st(sr, sc), vst1 = v_st(32 + sr, sc);
  const int vb0 = (int)(uintptr_t)V_lds + v_rd_base(lane);
  bf16x8 vs0, vs1, ks0, ks1;
#define SLOAD(k0) do { vs0 = *reinterpret_cast<const bf16x8*>(&Vh[(long)((k0) + sr) * LDV + sc]); vs1 = *reinterpret_cast<const bf16x8*>(&Vh[(long)((k0) + 32 + sr) * LDV + sc]); \
    ks0 = *reinterpret_cast<const bf16x8*>(&Kh[(long)((k0) + sr) * LDK + sc]); ks1 = *reinterpret_cast<const bf16x8*>(&Kh[(long)((k0) + 32 + sr) * LDK + sc]); } while (0)
#define SWRITE(bb) do { *(bf16x8*)(V_lds + (bb) * SHM_V + vst0) = vs0; *(bf16x8*)(V_lds + (bb) * SHM_V + vst1) = vs1; const int kc = sc * 2; \
    *(bf16x8*)(K_lds + (bb) * SHM_K + KSWZ(sr, kc)) = ks0; *(bf16x8*)(K_lds + (bb) * SHM_K + KSWZ(32 + sr, kc)) = ks1; } while (0)
  f32x16 o[4] = {};
  float l = 0.f;
  constexpr int NT = SEQ / KVBLK;
  f32x16 cinit;
#pragma unroll
  for (int r = 0; r < 16; ++r) cinit[r] = MODE == 0 ? -A.shift : 0.f;
  if (MODE == 0) asm volatile("" : "+v"(cinit));
  const int nq = q0 + wq * QBLK + r32;
  float ldf = 0.f, nldb = 0.f;
  if (MODE == 1) { ldf = A.ldf[h] * 1.4426950408889634f; nldb = -A.ldb[h] * 1.4426950408889634f; }
  const int jlo = MODE == 1 ? 4 * qb : 0, jhi = MODE == 1 ? jlo + 4 : NT;
  SLOAD(jlo * KVBLK);
  if (MODE == 1) {
    const float nl = (float)(wq * QBLK + r32);
#pragma unroll
    for (int dir = 0; dir < 2; ++dir) {
      const float scl = dir == 0 ? __builtin_amdgcn_exp2f(ldf * (nl + 1.0f)) : __builtin_amdgcn_exp2f(-nldb * (256.0f - nl));
      bf16x8 qs[8];
#pragma unroll
      for (int d0 = 0; d0 < 8; ++d0) { const u32x4 w = *reinterpret_cast<const u32x4*>(&qr[d0]); u32x4 z;
#pragma unroll
        for (int i = 0; i < 4; ++i) z[i] = cvtpk(__uint_as_float(w[i] << 16) * scl, __uint_as_float(w[i] & 0xffff0000u) * scl);
        qs[d0] = *reinterpret_cast<const bf16x8*>(&z); }
      const bf16* STp = A.ST + ((size_t)((b * 4 + h) * 2 + dir) * 32 + qb) * 16384 + (size_t)r32 * 128 + hi * 8;
#pragma unroll
      for (int dvb = 0; dvb < 4; ++dvb)
#pragma unroll
        for (int d0 = 0; d0 < 8; ++d0) { const bf16x8 fr = *reinterpret_cast<const bf16x8*>(STp + dvb * 32 * 128 + d0 * 16);
          o[dvb] = __builtin_amdgcn_mfma_f32_32x32x16_bf16(qs[d0], fr, o[dvb], 0, 0, 0); }
    }
  }
  asm volatile("s_waitcnt vmcnt(0)" ::: "memory"); SWRITE(jlo & 1); __syncthreads();
  for (int j = jlo; j < jhi; ++j) {
    const int buf = j & 1;
    if (j + 1 < jhi) SLOAD((j + 1) * KVBLK);
    const char* Ks = K_lds + buf * SHM_K; const int vb = vb0 + buf * SHM_V;
    f32x16 p0, p1; bf16x8 pa0, pa1, pa2, pa3;
    qkt<ND>(p0, p1, Ks, qr, r32, hi, c * 4, cinit);
    if (MODE == 0) {
      float ps = 0.f;
#pragma unroll
      for (int r = 0; r < 16; ++r) { float a = p0[r], e = p1[r]; a = __builtin_amdgcn_exp2f(a); e = __builtin_amdgcn_exp2f(e); p0[r] = a; p1[r] = e; ps += a + e; }
      l += ps;
    } else {
      const float dbase = (float)(nq - j * KVBLK - 4 * hi);
#pragma unroll
      for (int r = 0; r < 16; ++r) { const float d = dbase - (float)((r & 3) + 8 * (r >> 2)), d2 = d - 32.0f;
        p0[r] *= __builtin_amdgcn_exp2f(d * (d >= 0.f ? ldf : nldb));
        p1[r] *= __builtin_amdgcn_exp2f(d2 * (d2 >= 0.f ? ldf : nldb)); }
    }
    packP(p0, p1, pa0, pa1, pa2, pa3);
    pv_d0(o, vb, pa0, pa1, pa2, pa3);
    if (j + 1 < jhi) { asm volatile("s_waitcnt vmcnt(0)" ::: "memory"); SWRITE(buf ^ 1); }
    __syncthreads();
  }
#undef SLOAD
#undef SWRITE
  const long trow0 = tok0 + q0 + wq * QBLK;
  if (MODE == 0) {
    { auto rr = __builtin_amdgcn_permlane32_swap(__float_as_uint(l), __float_as_uint(l), false, false); l = __uint_as_float(rr[0]) + __uint_as_float(rr[1]); }
    if (hi == 0) ws[r32] = (c == 0 ? 1.0f : A.lam) / l;
    asm volatile("s_waitcnt lgkmcnt(0)" ::: "memory");
    float* xb = (float*)lds + (wq * QBLK) * 128;
    if (c == 1) {
#pragma unroll
      for (int r = 0; r < 16; ++r) { const int orow = crow(r, hi); const float a1 = ws[orow];
#pragma unroll
        for (int d0 = 0; d0 < 4; ++d0) xb[orow * 128 + d0 * 32 + r32] = o[d0][r] * a1; }
    }
    __syncthreads();
    if (c == 0) {
#pragma unroll
      for (int r = 0; r < 16; ++r) { const int orow = crow(r, hi); const float a0 = ws[orow];
        float v[4]; float ss = 0.f;
#pragma unroll
        for (int d0 = 0; d0 < 4; ++d0) { v[d0] = o[d0][r] * a0 - xb[orow * 128 + d0 * 32 + r32]; ss += v[d0] * v[d0]; }
        ss += __shfl_xor(ss, 1); ss += __shfl_xor(ss, 2); ss += __shfl_xor(ss, 4); ss += __shfl_xor(ss, 8); ss += __shfl_xor(ss, 16);
        const float rstd = 0.8f * rsqrtf(ss * (1.0f / 128.0f) + 1e-6f);
        bf16* orp = A.MIXED + (trow0 + orow) * 1024 + 512 + h * 128;
#pragma unroll
        for (int d0 = 0; d0 < 4; ++d0) orp[d0 * 32 + r32] = f2bf(v[d0] * rstd * A.dnw[d0 * 32 + r32]); }
    }
  } else {
#pragma unroll
    for (int r = 0; r < 16; ++r) { const int orow = crow(r, hi);
      float v[4]; float ss = 0.f;
#pragma unroll
      for (int d0 = 0; d0 < 4; ++d0) { v[d0] = o[d0][r]; ss += v[d0] * v[d0]; }
      ss += __shfl_xor(ss, 1); ss += __shfl_xor(ss, 2); ss += __shfl_xor(ss, 4); ss += __shfl_xor(ss, 8); ss += __shfl_xor(ss, 16);
      const float rstd = rsqrtf(ss * (1.0f / 128.0f) + 1e-6f);
      bf16* orp = A.MIXED + (trow0 + orow) * 1024 + h * 128;
      const bf16* grp = A.PROJ + (trow0 + orow) * 3584 + 1536 + h * 128;
#pragma unroll
      for (int d0 = 0; d0 < 4; ++d0) { const float g = bf2f(grp[d0 * 32 + r32]); const float sg = g / (1.0f + __expf(-g));
        orp[d0 * 32 + r32] = f2bf(v[d0] * rstd * A.rnw[h * 128 + d0 * 32 + r32] * sg); } }
  }
  __syncthreads();
}

#define LASM __attribute__((address_space(3)))
constexpr int AT_NS = 4, AT_SLOT = 16384, AT_VOFF = AT_NS * AT_SLOT, AT_WS = 2 * AT_NS * AT_SLOT, AT_LDS = AT_WS + NW * 256;
template <int OFF> __device__ __forceinline__ s16x4 trd(int vb) { s16x4 r; asm volatile("ds_read_b64_tr_b16 %0, %1 offset:%2" : "=&v"(r) : "v"(vb), "i"(OFF) : "memory"); return r; }
struct VFr { s16x4 l0, h0, l1, h1, l2, h2, l3, h3; };
__device__ __forceinline__ void vrd(VFr& f, int vb) { f.l0 = trd<0>(vb); f.h0 = trd<2048>(vb); f.l1 = trd<4096>(vb); f.h1 = trd<6144>(vb); f.l2 = trd<8192>(vb); f.h2 = trd<10240>(vb); f.l3 = trd<12288>(vb); f.h3 = trd<14336>(vb); }
__device__ __forceinline__ void pvm(f32x16& od, const VFr& f, bf16x8 pa0, bf16x8 pa1, bf16x8 pa2, bf16x8 pa3) {
#define PK(L, H) (bf16x8){L[0], L[1], L[2], L[3], H[0], H[1], H[2], H[3]}
  od = __builtin_amdgcn_mfma_f32_32x32x16_bf16(pa0, PK(f.l0, f.h0), od, 0, 0, 0);
  od = __builtin_amdgcn_mfma_f32_32x32x16_bf16(pa1, PK(f.l1, f.h1), od, 0, 0, 0);
  od = __builtin_amdgcn_mfma_f32_32x32x16_bf16(pa2, PK(f.l2, f.h2), od, 0, 0, 0);
  od = __builtin_amdgcn_mfma_f32_32x32x16_bf16(pa3, PK(f.l3, f.h3), od, 0, 0, 0);
#undef PK
}
__device__ __forceinline__ void pv_tile(f32x16* o, const int* vbase, int so, bf16x8 pa0, bf16x8 pa1, bf16x8 pa2, bf16x8 pa3) {
  VFr fa, fb;
  vrd(fa, vbase[0] + so); vrd(fb, vbase[1] + so);
  asm volatile("s_waitcnt lgkmcnt(8)" ::: "memory"); SBAR();
  pvm(o[0], fa, pa0, pa1, pa2, pa3); SBAR();
  vrd(fa, vbase[2] + so);
  asm volatile("s_waitcnt lgkmcnt(8)" ::: "memory"); SBAR();
  pvm(o[1], fb, pa0, pa1, pa2, pa3); SBAR();
  vrd(fb, vbase[3] + so);
  asm volatile("s_waitcnt lgkmcnt(8)" ::: "memory"); SBAR();
  pvm(o[2], fa, pa0, pa1, pa2, pa3); SBAR();
  asm volatile("s_waitcnt lgkmcnt(0)" ::: "memory"); SBAR();
  pvm(o[3], fb, pa0, pa1, pa2, pa3);
}
__device__ __forceinline__ void softmax_pack(f32x16& p0, f32x16& p1, float& l, bf16x8& pa0, bf16x8& pa1, bf16x8& pa2, bf16x8& pa3) {
  float s0 = 0.f, s1 = 0.f;
#pragma unroll
  for (int r = 0; r < 16; ++r) { p0[r] = __builtin_amdgcn_exp2f(p0[r]); p1[r] = __builtin_amdgcn_exp2f(p1[r]); s0 += p0[r]; s1 += p1[r]; }
  l += s0 + s1;
  u32x4 w;
  w = (u32x4){cvtpk(p0[0], p0[1]), cvtpk(p0[2], p0[3]), cvtpk(p0[4], p0[5]), cvtpk(p0[6], p0[7])};   pa0 = *reinterpret_cast<bf16x8*>(&w);
  w = (u32x4){cvtpk(p0[8], p0[9]), cvtpk(p0[10], p0[11]), cvtpk(p0[12], p0[13]), cvtpk(p0[14], p0[15])}; pa1 = *reinterpret_cast<bf16x8*>(&w);
  w = (u32x4){cvtpk(p1[0], p1[1]), cvtpk(p1[2], p1[3]), cvtpk(p1[4], p1[5]), cvtpk(p1[6], p1[7])};   pa2 = *reinterpret_cast<bf16x8*>(&w);
  w = (u32x4){cvtpk(p1[8], p1[9]), cvtpk(p1[10], p1[11]), cvtpk(p1[12], p1[13]), cvtpk(p1[14], p1[15])}; pa3 = *reinterpret_cast<bf16x8*>(&w);
}
template <bool SHIFT>
__device__ __forceinline__ void attn_unit(const MixArgs& A, int b, int h, int qb, char* lds, LASM unsigned char* ldsl) {
  const int tid = ltid(), wid = __builtin_amdgcn_readfirstlane(tid >> 6), lane = tid & 63, r32 = lane & 31, hi = lane >> 5;
  const int c = wid >> 2, wq = wid & 3;
  float* ws = (float*)(lds + AT_WS) + wid * 64;
  const int q0 = qb * 128; const long tok0 = (long)b * SEQ;
  const bf16* Qw = A.DQ + (tok0 + q0 + wq * QBLK + r32) * 512 + h * 128 + c * 64 + hi * 8;
  const bf16* Kh = A.DK + tok0 * 512 + h * 128; const bf16* Vh = A.PROJ + tok0 * 3584 + 3072 + h * 128;
  const int rsub = lane >> 4, chl = lane & 15, krow = 4 * wid + rsub;
  const bf16* ksrc = Kh + (long)krow * 512 + ((chl ^ (krow & 7)) << 3);
  const bf16* vsrc = Vh + (long)krow * 3584 + ((chl ^ (rsub << 2)) << 3);
#define ADMA_K(t) do { const int sl_ = ((t) & (AT_NS - 1)) * AT_SLOT + wid * 1024; const bf16* kp_ = ksrc + (long)(t) * (KVBLK * 512); \
    __builtin_amdgcn_global_load_lds((const unsigned*)kp_, (LASM unsigned*)(ldsl + sl_), 16, 0, 0); \
    __builtin_amdgcn_global_load_lds((const unsigned*)(kp_ + 32 * 512), (LASM unsigned*)(ldsl + sl_ + 8192), 16, 0, 0); } while (0)
#define ADMA_V(t) do { const int sl_ = ((t) & (AT_NS - 1)) * AT_SLOT + wid * 1024; const bf16* vp_ = vsrc + (long)(t) * (KVBLK * 3584); \
    __builtin_amdgcn_global_load_lds((const unsigned*)vp_, (LASM unsigned*)(ldsl + AT_VOFF + sl_), 16, 0, 0); \
    __builtin_amdgcn_global_load_lds((const unsigned*)(vp_ + 32 * 3584), (LASM unsigned*)(ldsl + AT_VOFF + sl_ + 8192), 16, 0, 0); } while (0)
  ADMA_K(0); ADMA_V(0); ADMA_K(1); ADMA_V(1); ADMA_K(2);
  bf16x8 qr[4];
#pragma unroll
  for (int d0 = 0; d0 < 4; ++d0) qr[d0] = *reinterpret_cast<const bf16x8*>(Qw + d0 * 16);
  int vbase[4];
  { const int q = (lane >> 2) & 3, p = lane & 3, g1 = (lane >> 4) & 1;
#pragma unroll
    for (int d0 = 0; d0 < 4; ++d0) vbase[d0] = (int)(uintptr_t)lds + AT_VOFF + (4 * hi + q) * 256 + ((d0 ^ q) << 6) + g1 * 32 + (p >> 1) * 16 + (p & 1) * 8; }
  f32x16 cinit;
#pragma unroll
  for (int r = 0; r < 16; ++r) cinit[r] = SHIFT ? -A.shift : 0.f;
  if (SHIFT) asm volatile("" : "+v"(cinit));
  f32x16 o[4] = {};
  float l = 0.f;
  constexpr int NT = SEQ / KVBLK;
  f32x16 pA0, pA1, pB0, pB1; bf16x8 pa0, pa1, pa2, pa3;
  asm volatile("s_waitcnt vmcnt(0)\n\ts_barrier" ::: "memory");
  qkt<4>(pA0, pA1, lds, qr, r32, hi, c * 4, cinit);
#define ASTEP(PC0, PC1, PN0, PN1, t) do { \
    if ((t) + 2 < NT) asm volatile("s_waitcnt vmcnt(4) lgkmcnt(0)\n\ts_barrier" ::: "memory"); else asm volatile("s_waitcnt vmcnt(0) lgkmcnt(0)\n\ts_barrier" ::: "memory"); \
    if ((t) + 3 < NT) ADMA_K((t) + 3); \
    if ((t) + 2 < NT) ADMA_V((t) + 2); \
    if (c == 1 && (t) > 0) pv_tile(o, vbase, (((t) - 1) & (AT_NS - 1)) * AT_SLOT, pa0, pa1, pa2, pa3); \
    if ((t) + 1 < NT) qkt<4>(PN0, PN1, lds + (((t) + 1) & (AT_NS - 1)) * AT_SLOT, qr, r32, hi, c * 4, cinit); \
    softmax_pack(PC0, PC1, l, pa0, pa1, pa2, pa3); \
    if (c == 0) pv_tile(o, vbase, ((t) & (AT_NS - 1)) * AT_SLOT, pa0, pa1, pa2, pa3); \
  } while (0)
  for (int t = 0; t < NT; t += 2) { ASTEP(pA0, pA1, pB0, pB1, t); ASTEP(pB0, pB1, pA0, pA1, t + 1); }
  if (c == 1) pv_tile(o, vbase, ((NT - 1) & (AT_NS - 1)) * AT_SLOT, pa0, pa1, pa2, pa3);
#undef ASTEP
#undef ADMA_K
#undef ADMA_V
  asm volatile("s_waitcnt vmcnt(0) lgkmcnt(0)\n\ts_barrier" ::: "memory");
  const long trow0 = tok0 + q0 + wq * QBLK;
  { auto rr = __builtin_amdgcn_permlane32_swap(__float_as_uint(l), __float_as_uint(l), false, false); l = __uint_as_float(rr[0]) + __uint_as_float(rr[1]); }
  if (hi == 0) ws[r32] = (c == 0 ? 1.0f : A.lam) / l;
  asm volatile("s_waitcnt lgkmcnt(0)" ::: "memory");
  float* xb = (float*)lds + (wq * QBLK) * 128;
  if (c == 1) {
#pragma unroll
    for (int r = 0; r < 16; ++r) { const int orow = crow(r, hi); const float a1 = ws[orow];
#pragma unroll
      for (int d0 = 0; d0 < 4; ++d0) xb[orow * 128 + d0 * 32 + r32] = o[d0][r] * a1; }
  }
  __syncthreads();
  if (c == 0) {
#pragma unroll
    for (int r = 0; r < 16; ++r) { const int orow = crow(r, hi); const float a0 = ws[orow];
      float v[4]; float ss = 0.f;
#pragma unroll
      for (int d0 = 0; d0 < 4; ++d0) { v[d0] = o[d0][r] * a0 - xb[orow * 128 + d0 * 32 + r32]; ss += v[d0] * v[d0]; }
      ss += __shfl_xor(ss, 1); ss += __shfl_xor(ss, 2); ss += __shfl_xor(ss, 4); ss += __shfl_xor(ss, 8); ss += __shfl_xor(ss, 16);
      const float rstd = 0.8f * rsqrtf(ss * (1.0f / 128.0f) + 1e-6f);
      bf16* orp = A.MIXED + (trow0 + orow) * 1024 + 512 + h * 128;
#pragma unroll
      for (int d0 = 0; d0 < 4; ++d0) orp[d0 * 32 + r32] = f2bf(v[d0] * rstd * A.dnw[d0 * 32 + r32]); }
  }
  __syncthreads();
}

__device__ __forceinline__ s16x4 tr_read_rt(int addr) { s16x4 r; asm volatile("ds_read_b64_tr_b16 %0, %1" : "=&v"(r) : "v"(addr) : "memory"); return r; }
__device__ __forceinline__ void kv_unit(const MixArgs& A, int b, int h, int ch, char* lds) {
  const int tid = ltid(), wid = __builtin_amdgcn_readfirstlane(tid >> 6), lane = tid & 63, r32 = lane & 31, hi = lane >> 5;
  constexpr int IMG = 16384, BUFB = 3 * IMG;
  const long tok0 = (long)b * SEQ; const int k0 = ch * 256;
  const bf16* Vh = A.PROJ + tok0 * 3584 + 1024 + h * 128; const bf16* KFh = A.RKF + (long)(b * 4 + h) * SEQ * 128; const bf16* KBh = A.RKB + (long)(b * 4 + h) * SEQ * 128;
  const int sr = tid >> 4, sc = (tid & 15) * 8, vst0 = v_st(sr, sc), vst1 = v_st(32 + sr, sc);
  const int dir = wid >> 2, dkb = wid & 3;
  bf16x8 s0, s1, s2, s3, s4, s5;
#define KLOAD(kk) do { s0 = *reinterpret_cast<const bf16x8*>(&Vh[(long)((kk) + sr) * 3584 + sc]); s1 = *reinterpret_cast<const bf16x8*>(&Vh[(long)((kk) + 32 + sr) * 3584 + sc]); \
    s2 = *reinterpret_cast<const bf16x8*>(&KFh[(long)((kk) + sr) * 128 + sc]); s3 = *reinterpret_cast<const bf16x8*>(&KFh[(long)((kk) + 32 + sr) * 128 + sc]); \
    s4 = *reinterpret_cast<const bf16x8*>(&KBh[(long)((kk) + sr) * 128 + sc]); s5 = *reinterpret_cast<const bf16x8*>(&KBh[(long)((kk) + 32 + sr) * 128 + sc]); } while (0)
#define KWRITE(bb) do { char* p_ = lds + (bb) * BUFB; *(bf16x8*)(p_ + vst0) = s0; *(bf16x8*)(p_ + vst1) = s1; *(bf16x8*)(p_ + IMG + vst0) = s2; *(bf16x8*)(p_ + IMG + vst1) = s3; \
    *(bf16x8*)(p_ + 2 * IMG + vst0) = s4; *(bf16x8*)(p_ + 2 * IMG + vst1) = s5; } while (0)
  f32x16 acc[4] = {};
  KLOAD(k0); asm volatile("s_waitcnt vmcnt(0)" ::: "memory"); KWRITE(0); __syncthreads();
  const int rdb = (int)(uintptr_t)lds + v_rd_base(lane);
  for (int j = 0; j < 4; ++j) {
    const int buf = j & 1;
    if (j + 1 < 4) KLOAD(k0 + (j + 1) * KVBLK);
    const int vb = rdb + buf * BUFB, kb = rdb + buf * BUFB + IMG * (1 + dir) + dkb * 512;
#pragma unroll
    for (int ks = 0; ks < 4; ++ks) {
      const s16x4 kl = tr_read_rt(kb + ks * 4096), kh = tr_read_rt(kb + ks * 4096 + 2048);
      s16x4 vl[4], vh[4];
#pragma unroll
      for (int dvb = 0; dvb < 4; ++dvb) { vl[dvb] = tr_read_rt(vb + dvb * 512 + ks * 4096); vh[dvb] = tr_read_rt(vb + dvb * 512 + ks * 4096 + 2048); }
      asm volatile("s_waitcnt lgkmcnt(0)" ::: "memory"); SBAR();
      const bf16x8 ka = (bf16x8){kl[0], kl[1], kl[2], kl[3], kh[0], kh[1], kh[2], kh[3]};
#pragma unroll
      for (int dvb = 0; dvb < 4; ++dvb) { const bf16x8 vf = (bf16x8){vl[dvb][0], vl[dvb][1], vl[dvb][2], vl[dvb][3], vh[dvb][0], vh[dvb][1], vh[dvb][2], vh[dvb][3]};
        acc[dvb] = __builtin_amdgcn_mfma_f32_32x32x16_bf16(ka, vf, acc[dvb], 0, 0, 0); }
    }
    if (j + 1 < 4) { asm volatile("s_waitcnt vmcnt(0)" ::: "memory"); KWRITE(buf ^ 1); }
    __syncthreads();
  }
#undef KLOAD
#undef KWRITE
  float* outp = A.KVT + ((size_t)((b * 4 + h) * 2 + dir) * 32 + ch) * 16384;
  using f32x4v = __attribute__((ext_vector_type(4))) float;
#pragma unroll
  for (int dvb = 0; dvb < 4; ++dvb)
#pragma unroll
    for (int g = 0; g < 4; ++g) { const f32x4v v = {acc[dvb][4 * g], acc[dvb][4 * g + 1], acc[dvb][4 * g + 2], acc[dvb][4 * g + 3]};
      *(f32x4v*)(outp + (size_t)(dvb * 32 + r32) * 128 + dkb * 32 + 8 * g + 4 * hi) = v; }
}
#undef SBAR
}
constexpr int NWAVES = 8;
constexpr int BATCH = 2, SEQ = 8192, DM = 1024, T = BATCH * SEQ, NPROJ = 3584, NEXP = 32, TOPK = 4, DFF = 1024;
constexpr float EPS = 1e-6f;
constexpr int MAXROWS = 73728;
constexpr int MAXTILES = MAXROWS / 256;
constexpr size_t MiB = 1u << 20;
constexpr size_t WS_CTL = 0, CTL_ZERO_BYTES = 1 * MiB;
constexpr size_t WS_WIN = 2 * MiB;
constexpr size_t WS_WOUT = 10 * MiB;
constexpr size_t WS_W1 = 16 * MiB;
constexpr size_t WS_W2 = 144 * MiB;
constexpr size_t WS_XN = 208 * MiB;
constexpr size_t WS_PROJ = 240 * MiB;
constexpr size_t WS_RQ = 352 * MiB, WS_RK = 368 * MiB, WS_DQ = 384 * MiB, WS_DK = 400 * MiB;
constexpr size_t WS_MIXED = 416 * MiB;
constexpr size_t WS_H2 = 448 * MiB;
constexpr size_t WS_SEL = 480 * MiB;
constexpr size_t WS_SLOT = WS_SEL + 256 * 1024;
constexpr size_t WS_GATE = WS_SLOT + 256 * 1024;
constexpr size_t WS_ROWS = WS_GATE + 256 * 1024;
constexpr size_t WS_GATEP = WS_ROWS + 256 * 1024;
constexpr size_t WS_XG = 482 * MiB;
constexpr size_t WS_RKF = 482 * MiB, WS_RKB = 498 * MiB, WS_KVT = 514 * MiB, WS_ST = 546 * MiB;
constexpr size_t WS_ACT = WS_PROJ;
constexpr size_t WS_X1 = 626 * MiB;
constexpr size_t WS_TOKE = 690 * MiB, WS_GATEE = 692 * MiB;
constexpr size_t WS_END = 694 * MiB;
static_assert(WS_GATEP + MAXROWS * 4 <= WS_XG && WS_ACT + (size_t)MAXROWS * 2048 <= WS_DQ && WS_XG + (size_t)MAXROWS * 2048 <= WS_END, "d_ws map");
constexpr int CW_CNT = 8192;
constexpr int CW_BAR = 4096;
constexpr int RING_OFF = 0, RING_BYTES = 131072;
constexpr int LDS_BYTES = 162816;
constexpr int MISC_OFF = 151552;
constexpr int TAB_OFF = 152064;
constexpr int ROUTE_OFF = 153600;
static_assert(TAB_OFF + 34 * 4 + MAXTILES <= ROUTE_OFF && ROUTE_OFF + 256 + 64 * 4 * 8 <= LDS_BYTES, "LDS map");

#define GAS __attribute__((address_space(1)))
#define LAS __attribute__((address_space(3)))
typedef unsigned short bf16;
typedef unsigned v4u __attribute__((ext_vector_type(4)));
typedef unsigned v2u __attribute__((ext_vector_type(2)));
typedef float f32x4 __attribute__((ext_vector_type(4)));
typedef float f32x2 __attribute__((ext_vector_type(2)));
typedef short bf16x8 __attribute__((ext_vector_type(8)));
typedef GAS unsigned gu32;
#define RLX_AGENT __ATOMIC_RELAXED, __HIP_MEMORY_SCOPE_AGENT
#define LDS_WAIT() asm volatile("s_waitcnt lgkmcnt(0)" ::: "memory")
#define VM_WAIT() asm volatile("s_waitcnt vmcnt(0)" ::: "memory")
__device__ __forceinline__ unsigned pk2(float lo, float hi) { unsigned r; asm volatile("v_cvt_pk_bf16_f32 %0, %1, %2" : "=v"(r) : "v"(lo), "v"(hi)); return r; }
__device__ __forceinline__ float bflo(unsigned w) { return __uint_as_float(w << 16); }
__device__ __forceinline__ float bfhi(unsigned w) { return __uint_as_float(w & 0xffff0000u); }
__device__ __forceinline__ float wave_sum(float v) {
#pragma unroll
    for (int o = 1; o < 64; o <<= 1) v += __shfl_xor(v, o);
    return v;
}
__device__ __forceinline__ float wave_max(float v) {
#pragma unroll
    for (int o = 1; o < 64; o <<= 1) v = fmaxf(v, __shfl_xor(v, o));
    return v;
}
#define XB_TMO      128
#define XB_XCNT(j)  (256  + 64 * (j))
#define XB_XSUB(j)  (1280 + 64 * (j))
#define XB_XGEN(j)  (2304 + 64 * (j))
#define XB_TOP      3328
#define XB_TOPGEN   3392
#define XCD_BAR_WORDS 3456
#define XB_SPIN_CAP (1u << 18)

__device__ __forceinline__ unsigned xb_ld(unsigned* p)              { return __hip_atomic_load(p, __ATOMIC_RELAXED, __HIP_MEMORY_SCOPE_AGENT); }
__device__ __forceinline__ unsigned xb_add(unsigned* p, unsigned v) { return __hip_atomic_fetch_add(p, v, __ATOMIC_RELAXED, __HIP_MEMORY_SCOPE_AGENT); }
__device__ __forceinline__ unsigned xb_xcc_id() { return (unsigned)__builtin_amdgcn_s_getreg((3 << 11) | 20) & 0xFu; }
#define XB_SPIN(cond, bar) do { unsigned _sp = 0; while (cond) { __builtin_amdgcn_s_sleep(1); \
    if ((++_sp & 255u) == 0u) { if (xb_ld(&(bar)[XB_TMO])) break; if (_sp > XB_SPIN_CAP) { atomicAdd(&(bar)[XB_TMO], 1u); break; } } } } while (0)

struct XcdBarrier {
    unsigned* bar; unsigned x;
    volatile LAS unsigned* st;
};

__device__ __forceinline__ XcdBarrier xcd_barrier_post(unsigned* bar, volatile LAS unsigned* st) {
    XcdBarrier b; b.bar = bar; b.x = xb_xcc_id(); b.st = st;
    if (threadIdx.x == 0) (void)xb_add(&bar[XB_XCNT(b.x)], 1u);
    return b;
}
__device__ __forceinline__ void xcd_barrier_complete(unsigned* bar, unsigned x, unsigned& nloc, unsigned& nx) {
    const unsigned G = gridDim.x * gridDim.y * gridDim.z;
    unsigned sum, cnt, mine, sp = 0u;
    for (;;) {
        sum = 0u; cnt = 0u; mine = 0u;
#pragma unroll
        for (unsigned j = 0; j < 16; ++j) { const unsigned c = xb_ld(&bar[XB_XCNT(j)]); sum += c; cnt += (c > 0u) ? 1u : 0u; mine = (j == x) ? c : mine; }
        if (sum == G) break;
        __builtin_amdgcn_s_sleep(1);
        if ((++sp & 255u) == 0u) { if (xb_ld(&bar[XB_TMO])) break; if (sp > XB_SPIN_CAP) { atomicAdd(&bar[XB_TMO], 1u); break; } }
    }
    nloc = mine > 0u ? mine : 1u; nx = cnt > 0u ? cnt : 1u;
}

__device__ __forceinline__ void xcd_barrier(const XcdBarrier& b) {
    asm volatile("s_waitcnt vmcnt(0)" ::: "memory");
    __syncthreads();
    if (threadIdx.x == 0) {
        unsigned* bar = b.bar;
        __builtin_amdgcn_s_waitcnt(0);
        unsigned nloc = b.st[0], nx = b.st[1];
        if (nloc == 0u) { xcd_barrier_complete(bar, b.x, nloc, nx); b.st[0] = nloc; b.st[1] = nx; }
        const unsigned old = xb_add(&bar[XB_XSUB(b.x)], 1u);
        const unsigned gen = old / nloc;
        if (old + 1u == (gen + 1u) * nloc) {
            __builtin_amdgcn_fence(__ATOMIC_RELEASE, "agent");
            asm volatile("s_waitcnt vmcnt(0)" ::: "memory");
            const unsigned og = xb_add(&bar[XB_TOP], 1u);
            const unsigned tg = og / nx;
            if (og + 1u == (tg + 1u) * nx) xb_add(&bar[XB_TOPGEN], 1u);
            else XB_SPIN(xb_ld(&bar[XB_TOPGEN]) == tg, bar);
            __builtin_amdgcn_fence(__ATOMIC_ACQUIRE, "agent");
            xb_add(&bar[XB_XGEN(b.x)], 1u);
            asm volatile("s_waitcnt vmcnt(0)" ::: "memory");
        } else {
            XB_SPIN(xb_ld(&bar[XB_XGEN(b.x)]) == gen, bar);
            __builtin_amdgcn_fence(__ATOMIC_ACQUIRE, "agent");
            asm volatile("s_waitcnt vmcnt(0)" ::: "memory");
        }
    }
    __syncthreads();
}
struct Ctx {
    LAS unsigned char* lds; unsigned char* ws; gu32* ctl; const void* const* in; float* out;
    int tid, lane, wave, vcu, G, gw, NGW;
};
__device__ __forceinline__ void tr_item(const float* W, int K, int N, bf16* WT, int kb, int nb, int orow0, LAS float* scr, int lane) {
    const int k0 = 64 * kb, n0 = 32 * nb;
#pragma unroll 8
    for (int i = 0; i < 32; ++i) { const int kk = 2 * i + (lane >> 5); scr[kk * 33 + (lane & 31)] = W[(size_t)(k0 + kk) * N + n0 + (lane & 31)]; }
    LDS_WAIT(); asm volatile("" ::: "memory");
    const int c = lane & 7;
#pragma unroll
    for (int j = 0; j < 4; ++j) { const int n = (lane >> 3) + 8 * j; const LAS float* s = scr + (8 * c) * 33 + n;
        v4u o; o.x = pk2(s[0 * 33], s[1 * 33]); o.y = pk2(s[2 * 33], s[3 * 33]); o.z = pk2(s[4 * 33], s[5 * 33]); o.w = pk2(s[6 * 33], s[7 * 33]);
        *(GAS v4u*)(WT + (size_t)(orow0 + n) * K + k0 + 8 * c) = o; }
    LDS_WAIT(); asm volatile("" ::: "memory");
}
__device__ __forceinline__ void phase_prologue(const Ctx& C) {
    LAS float* scr = (LAS float*)(C.lds + C.wave * 16384);
    const float* w_in = (const float*)C.in[3]; const float* w_out = (const float*)C.in[14]; const float* w1 = (const float*)C.in[18]; const float* w2 = (const float*)C.in[20];
    bf16* WIN = (bf16*)(C.ws + WS_WIN); bf16* WOUT = (bf16*)(C.ws + WS_WOUT); bf16* W1T = (bf16*)(C.ws + WS_W1); bf16* W2T = (bf16*)(C.ws + WS_W2);
    constexpr int I_IN = 16 * 112, I_OUT = 16 * 32, I_W1 = 32 * 16 * 64, I_W2 = 32 * 16 * 32, NITEMS = I_IN + I_OUT + I_W1 + I_W2;
    for (int it = C.gw; it < NITEMS; it += C.NGW) {
        int r = it;
        if (r < I_IN) { tr_item(w_in, 1024, NPROJ, WIN, r / 112, r % 112, 32 * (r % 112), scr, C.lane); continue; } r -= I_IN;
        if (r < I_OUT) { tr_item(w_out, 1024, 1024, WOUT, r / 32, r % 32, 32 * (r % 32), scr, C.lane); continue; } r -= I_OUT;
        if (r < I_W1) { const int e = r >> 10, rr = r & 1023, kb = rr >> 6, nb = rr & 63, n0 = 32 * nb;
            const int orow0 = (n0 < 1024) ? 256 * (n0 >> 7) + (n0 & 127) : 256 * ((n0 - 1024) >> 7) + 128 + ((n0 - 1024) & 127);
            tr_item(w1 + (size_t)e * 1024 * 2048, 1024, 2048, W1T + (size_t)e * 2048 * 1024, kb, nb, orow0, scr, C.lane); continue; } r -= I_W1;
        { const int e = r >> 9, rr = r & 511, kb = rr >> 5, nb = rr & 31;
            tr_item(w2 + (size_t)e * 1024 * 1024, 1024, 1024, W2T + (size_t)e * 1024 * 1024, kb, nb, 32 * nb, scr, C.lane); }
    }
    const float* x = (const float*)C.in[0]; const float* n1w = (const float*)C.in[2]; bf16* XN = (bf16*)(C.ws + WS_XN);
    f32x4 wv[4];
#pragma unroll
    for (int j = 0; j < 4; ++j) wv[j] = ((const GAS f32x4*)n1w)[C.lane + 64 * j];
    for (int m = C.gw; m < T; m += C.NGW) {
        const GAS f32x4* xr = (const GAS f32x4*)(x + (size_t)m * DM) + C.lane;
        f32x4 v[4]; float s = 0.f;
#pragma unroll
        for (int j = 0; j < 4; ++j) { v[j] = xr[64 * j]; s += (v[j].x * v[j].x + v[j].y * v[j].y) + (v[j].z * v[j].z + v[j].w * v[j].w); }
        const float rstd = rsqrtf(wave_sum(s) * (1.f / DM) + EPS);
        GAS v2u* o8 = (GAS v2u*)(XN + (size_t)m * DM) + C.lane;
#pragma unroll
        for (int j = 0; j < 4; ++j) { const f32x4 y = v[j] * rstd * wv[j]; v2u o; o.x = pk2(y.x, y.y); o.y = pk2(y.z, y.w); o8[64 * j] = o; }
    }
}
__device__ __forceinline__ double dexp_small(double y) {
    const double z = y * (1.0 / 1024.0);
    double r = 1.0 + z * (1.0 + z * (0.5 + z * (1.0 / 6.0 + z * (1.0 / 24.0 + z * (1.0 / 120.0 + z * (1.0 / 720.0))))));
#pragma unroll
    for (int i = 0; i < 10; ++i) r *= r;
    return r;
}
__device__ __forceinline__ void unpack8(const v4u w, float (&f)[8]) {
#pragma unroll
    for (int j = 0; j < 4; ++j) { f[2 * j] = bflo(w[j]); f[2 * j + 1] = bfhi(w[j]); }
}
__device__ __forceinline__ v4u pack8(const float (&f)[8]) { v4u w; w.x = pk2(f[0], f[1]); w.y = pk2(f[2], f[3]); w.z = pk2(f[4], f[5]); w.w = pk2(f[6], f[7]); return w; }
constexpr float QSCALE = 0.125f * 1.4426950408889634f;
__device__ __forceinline__ void phase_qk(const Ctx& C) {
    LAS double* revt = (LAS double*)(C.lds);
    if (C.tid < 72) { const double y = C.tid < 64 ? -((double)C.tid / 63.0) * 9.210340371976184 : -((double)(C.tid - 64) / 8.0) * 13.122363377404328;
        revt[C.tid] = dexp_small(y) * 0.15915494309189535; }
    __syncthreads();
    const int* positions = (const int*)C.in[1]; const float* qnw = (const float*)C.in[7]; const float* knw = (const float*)C.in[8];
    const bf16* PROJ = (const bf16*)(C.ws + WS_PROJ);
    bf16* RQ = (bf16*)(C.ws + WS_RQ); bf16* RK = (bf16*)(C.ws + WS_RK); bf16* DQ = (bf16*)(C.ws + WS_DQ); bf16* DK = (bf16*)(C.ws + WS_DK);
    bf16* RKF = (bf16*)(C.ws + WS_RKF); bf16* RKB = (bf16*)(C.ws + WS_RKB);
    const int L = C.lane;
    const float ldf2 = ((const float*)C.in[4])[L >> 4] * 1.4426950408889634f, ldb2 = ((const float*)C.in[5])[L >> 4] * 1.4426950408889634f;
    float qw[8], kw[8];
#pragma unroll
    for (int e = 0; e < 8; ++e) { qw[e] = qnw[(L & 7) * 8 + e]; kw[e] = knw[(L & 7) * 8 + e]; }
    for (int t = C.gw; t < T; t += C.NGW) {
        const int b = t / SEQ, s = t % SEQ; const double pos = (double)positions[t];
        const bf16* prow = PROJ + (size_t)t * NPROJ;
        {
            float qf[8], kf[8], qo[8], ko[8];
            unpack8(*(const GAS v4u*)(prow + 8 * L), qf); unpack8(*(const GAS v4u*)(prow + 512 + 8 * L), kf);
            const int head = L >> 4, half = (L >> 3) & 1, i0 = (L & 7) * 8;
#pragma unroll
            for (int e = 0; e < 8; ++e) { double a = pos * revt[i0 + e]; a -= rint(a); const float fr = (float)a;
                const float c = __builtin_amdgcn_cosf(fr), sn = __builtin_amdgcn_sinf(fr);
                const float qp = __shfl_xor(qf[e], 8), kp = __shfl_xor(kf[e], 8);
                qo[e] = half ? qf[e] * c + qp * sn : qf[e] * c - qp * sn;
                ko[e] = (half ? kf[e] * c + kp * sn : kf[e] * c - kp * sn) * 0.08838834764831845f; }
            const size_t o = ((size_t)(b * 4 + head) * SEQ + s) * 128 + (L & 15) * 8;
            *(GAS v4u*)(RQ + o) = pack8(qo); *(GAS v4u*)(RK + o) = pack8(ko);
            const float ml = (float)(s & 255), wf = __builtin_amdgcn_exp2f(ldf2 * (255.0f - ml)), wb = __builtin_amdgcn_exp2f(ldb2 * ml);
#pragma unroll
            for (int e = 0; e < 8; ++e) { qo[e] = ko[e] * wf; ko[e] = ko[e] * wb; }
            *(GAS v4u*)(RKF + o) = pack8(qo); *(GAS v4u*)(RKB + o) = pack8(ko);
        }
        {
            float qf[8], kf[8];
            unpack8(*(const GAS v4u*)(prow + 2048 + 8 * L), qf); unpack8(*(const GAS v4u*)(prow + 2560 + 8 * L), kf);
            float sq = 0.f, sk = 0.f;
#pragma unroll
            for (int e = 0; e < 8; ++e) { sq += qf[e] * qf[e]; sk += kf[e] * kf[e]; }
            sq += __shfl_xor(sq, 1); sq += __shfl_xor(sq, 2); sq += __shfl_xor(sq, 4);
            sk += __shfl_xor(sk, 1); sk += __shfl_xor(sk, 2); sk += __shfl_xor(sk, 4);
            const float rq = rsqrtf(sq * (1.f / 64.f) + EPS), rk = rsqrtf(sk * (1.f / 64.f) + EPS);
            const int sel = L & 7;
#pragma unroll
            for (int e = 0; e < 8; ++e) { float y = qf[e] * rq * qw[e], z = kf[e] * rk * kw[e];
                double a = pos * revt[64 + e]; a -= rint(a); const float fr = (float)a;
                const float c = __builtin_amdgcn_cosf(fr), sn = __builtin_amdgcn_sinf(fr);
                const float yp = __shfl_xor(y, 1), zp = __shfl_xor(z, 1);
                if (sel == 0) { y = y * c - yp * sn; z = z * c - zp * sn; }
                else if (sel == 1) { y = y * c + yp * sn; z = z * c + zp * sn; }
                qf[e] = y * QSCALE; kf[e] = z; }
            *(GAS v4u*)(DQ + (size_t)t * 512 + 8 * L) = pack8(qf); *(GAS v4u*)(DK + (size_t)t * 512 + 8 * L) = pack8(kf);
        }
    }
}
__device__ __forceinline__ void phase_mix(const Ctx& C, unsigned char* lds_generic, int part) {
    const float* qnw = (const float*)C.in[7]; const float* knw = (const float*)C.in[8];
    const float s1 = wave_sum(((const float*)C.in[9])[C.lane] * ((const float*)C.in[10])[C.lane]);
    const float s2 = wave_sum(((const float*)C.in[11])[C.lane] * ((const float*)C.in[12])[C.lane]);
    const float mq = wave_max(fabsf(qnw[C.lane])), mk = wave_max(fabsf(knw[C.lane]));
    const float bound = 8.0f * 1.4426950408889634f * mq * mk * 1.001f;
    mix::MixArgs A;
    A.DQ = (const bf16*)(C.ws + WS_DQ); A.DK = (const bf16*)(C.ws + WS_DK); A.RQ = (const bf16*)(C.ws + WS_RQ); A.RK = (const bf16*)(C.ws + WS_RK);
    A.PROJ = (const bf16*)(C.ws + WS_PROJ); A.MIXED = (bf16*)(C.ws + WS_MIXED);
    A.dnw = (const float*)C.in[13]; A.rnw = (const float*)C.in[6];
    A.lam = __int_as_float(__builtin_amdgcn_readfirstlane(__float_as_int(__expf(s1) - __expf(s2) + 0.2f)));
    A.shift = __int_as_float(__builtin_amdgcn_readfirstlane(__float_as_int(bound)));
    const bool need_shift = A.shift > 40.0f;
    A.ldf = (const float*)C.in[4]; A.ldb = (const float*)C.in[5];
    A.RKF = (const bf16*)(C.ws + WS_RKF); A.RKB = (const bf16*)(C.ws + WS_RKB); A.KVT = (float*)(C.ws + WS_KVT); A.ST = (const bf16*)(C.ws + WS_ST);
    if (part == 0) {
        if (need_shift) { for (int u = C.vcu; u < 512; u += C.G) { const int b = u >> 8, h = (u >> 6) & 3, qb = u & 63; mix::attn_unit<false>(A, b, h, qb, (char*)lds_generic, C.lds); } }
        else            { for (int u = C.vcu; u < 512; u += C.G) { const int b = u >> 8, h = (u >> 6) & 3, qb = u & 63; mix::attn_unit<false>(A, b, h, qb, (char*)lds_generic, C.lds); } }
        for (int u = C.vcu; u < 256; u += C.G) { const int b = u >> 7, h = (u >> 5) & 3, ch = u & 31; mix::kv_unit(A, b, h, ch, (char*)lds_generic); }
    } else {
        for (int u = C.vcu; u < 256; u += C.G) { const int b = u >> 7, h = (u >> 5) & 3, qb = u & 31; mix::mixer_unit<1>(A, b, h, qb, (char*)lds_generic); }
    }
}
__device__ __forceinline__ void phase_scan(const Ctx& C) {
    const float* KVT = (const float*)(C.ws + WS_KVT); bf16* ST = (bf16*)(C.ws + WS_ST);
    for (int gid = C.vcu * (NWAVES * 64) + C.tid; gid < 16 * 4096; gid += C.G * NWAVES * 64) {
        const int bhd = gid >> 12, e4 = gid & 4095, dir = bhd & 1, h = (bhd >> 1) & 3;
        const float ld = dir ? ((const float*)C.in[5])[h] : ((const float*)C.in[4])[h];
        const float g = __builtin_amdgcn_exp2f(ld * 1.4426950408889634f * 256.0f);
        const GAS f32x4* kv = (const GAS f32x4*)(KVT + (size_t)bhd * 32 * 16384) + e4;
        GAS v2u* st = (GAS v2u*)(ST + (size_t)bhd * 32 * 16384) + e4;
        f32x4 S = {0.f, 0.f, 0.f, 0.f};
        f32x4 kvr[32];
#pragma unroll
        for (int i = 0; i < 32; ++i) kvr[i] = kv[(size_t)i * 4096];
        if (dir == 0) {
#pragma unroll
            for (int i = 0; i < 32; ++i) { v2u o; o.x = pk2(S.x, S.y); o.y = pk2(S.z, S.w); st[(size_t)i * 4096] = o; S = S * g + kvr[i]; }
        } else {
#pragma unroll
            for (int i = 31; i >= 0; --i) { v2u o; o.x = pk2(S.x, S.y); o.y = pk2(S.z, S.w); st[(size_t)i * 4096] = o; S = S * g + kvr[i]; }
        }
    }
}
template <int N> __device__ __forceinline__ float row_ror(float v) { return __int_as_float(__builtin_amdgcn_update_dpp(0, __float_as_int(v), 0x120 + N, 0xf, 0xf, false)); }
__device__ __forceinline__ void reduce32(const float (&lg)[32], float (&out)[32]) {
    float a[16];
#pragma unroll
    for (int e = 0; e < 16; ++e) { auto r = __builtin_amdgcn_permlane32_swap(__float_as_uint(lg[e]), __float_as_uint(lg[e + 16]), false, false); a[e] = __uint_as_float(r[0]) + __uint_as_float(r[1]); }
    float c[8];
#pragma unroll
    for (int j = 0; j < 8; ++j) { auto r = __builtin_amdgcn_permlane16_swap(__float_as_uint(a[j]), __float_as_uint(a[j + 8]), false, false); c[j] = __uint_as_float(r[0]) + __uint_as_float(r[1]); }
#pragma unroll
    for (int j = 0; j < 8; ++j) { float v = c[j]; v += row_ror<8>(v); v += row_ror<4>(v); v += row_ror<2>(v); v += row_ror<1>(v); c[j] = v; }
#pragma unroll
    for (int r = 0; r < 4; ++r)
#pragma unroll
        for (int j = 0; j < 8; ++j) out[16 * (r >> 1) + 8 * (r & 1) + j] = __int_as_float(__builtin_amdgcn_readlane(__float_as_int(c[j]), 16 * r));
}
__device__ __forceinline__ void top4_gates(float (&lg)[32], int (&idx)[4], float (&gate)[4]) {
    float val[4];
#pragma unroll
    for (int k = 0; k < 4; ++k) { float best = -INFINITY; int bi = 0;
#pragma unroll
        for (int e = 0; e < 32; ++e) { if (lg[e] > best) { best = lg[e]; bi = e; } }
#pragma unroll
        for (int e = 0; e < 32; ++e) lg[e] = (e == bi) ? -INFINITY : lg[e];
        idx[k] = bi; val[k] = best; }
    float es = 0.f;
#pragma unroll
    for (int k = 0; k < 4; ++k) { gate[k] = __expf(val[k] - val[0]); es += gate[k]; }
    const float ri = 1.0f / es;
#pragma unroll
    for (int k = 0; k < 4; ++k) gate[k] *= ri;
}
__device__ __forceinline__ void phase_route(const Ctx& C) {
    const float* wr = (const float*)C.in[16]; const float* br = (const float*)C.in[17]; const float* n2w = (const float*)C.in[15];
    LAS float* wl = (LAS float*)C.lds;
    for (int i = C.tid; i < 1024 * 8; i += NWAVES * 64) { const int row = i >> 3, q = i & 7; *(LAS f32x4*)(wl + row * 36 + 4 * q) = ((const GAS f32x4*)wr)[i]; }
    bf16* H2 = (bf16*)(C.ws + WS_H2); int* SEL = (int*)(C.ws + WS_SEL); int* SLOT = (int*)(C.ws + WS_SLOT); float* GATE = (float*)(C.ws + WS_GATE);
    int* TOKE = (int*)(C.ws + WS_TOKE); float* GATEE = (float*)(C.ws + WS_GATEE);
    LAS int* lcnt = (LAS int*)(C.lds + ROUTE_OFF); LAS int* lbase = lcnt + 32; LAS int* rec = lcnt + 64;
    if (C.tid < 32) lcnt[C.tid] = 0;
    __syncthreads();
    float nw[16];
#pragma unroll
    for (int j = 0; j < 16; ++j) nw[j] = n2w[C.lane + 64 * j];
    int it_ = 0;
    for (int t = C.gw; t < T; t += C.NGW, ++it_) { const int slot_i = C.wave * 8 + it_;
        const float* xr = (const float*)(C.ws + WS_X1) + (size_t)t * DM;
        float xv[16]; float ss = 0.f;
#pragma unroll
        for (int j = 0; j < 16; ++j) { xv[j] = xr[C.lane + 64 * j]; ss += xv[j] * xv[j]; }
        const float rstd = rsqrtf(wave_sum(ss) * (1.f / DM) + EPS);
        float lp[32];
#pragma unroll
        for (int e = 0; e < 32; ++e) lp[e] = 0.f;
        bf16* hrow = H2 + (size_t)t * DM;
#pragma unroll
        for (int j = 0; j < 16; ++j) { const float h = xv[j] * rstd * nw[j]; hrow[C.lane + 64 * j] = (bf16)(pk2(h, h) & 0xffffu);
            const LAS f32x4* wp = (const LAS f32x4*)(wl + (C.lane + 64 * j) * 36);
#pragma unroll
            for (int q = 0; q < 8; ++q) { const f32x4 w4 = wp[q]; lp[4 * q] += h * w4.x; lp[4 * q + 1] += h * w4.y; lp[4 * q + 2] += h * w4.z; lp[4 * q + 3] += h * w4.w; } }
        float lg[32]; reduce32(lp, lg);
#pragma unroll
        for (int e = 0; e < 32; ++e) lg[e] += br[e];
        int idx[4]; float gate[4]; top4_gates(lg, idx, gate);
        if (C.lane == 0) {
#pragma unroll
            for (int k = 0; k < 4; ++k) { const int rk = __hip_atomic_fetch_add((LAS int*)(lcnt + idx[k]), 1, __ATOMIC_RELAXED, __HIP_MEMORY_SCOPE_WORKGROUP);
                rec[(slot_i * 4 + k) * 2] = (idx[k] << 16) | rk; rec[(slot_i * 4 + k) * 2 + 1] = __float_as_int(gate[k]); } }
    }
    __syncthreads();
    if (C.tid < 32) { const int n = lcnt[C.tid]; lbase[C.tid] = n ? (int)__hip_atomic_fetch_add((unsigned*)(C.ctl + CW_CNT + 64 * C.tid), (unsigned)n, __ATOMIC_RELAXED, __HIP_MEMORY_SCOPE_AGENT) : 0; }
    __syncthreads();
    { int it = 0;
      for (int t = C.gw; t < T; t += C.NGW, ++it) { const int slot_i = C.wave * 8 + it;
        if (C.lane < 4) { const int rr = rec[(slot_i * 4 + C.lane) * 2], e = rr >> 16, rk = rr & 0xffff;
            const int sl = lbase[e] + rk; const float gt = __int_as_float(rec[(slot_i * 4 + C.lane) * 2 + 1]);
            SEL[t * 4 + C.lane] = e; SLOT[t * 4 + C.lane] = sl; GATE[t * 4 + C.lane] = gt; TOKE[e * 16384 + sl] = t; GATEE[e * 16384 + sl] = gt; } } }
}
__device__ __forceinline__ void moe_tables(const Ctx& C) {
    LAS int* padoff = (LAS int*)(C.lds + TAB_OFF); LAS unsigned char* tile_e = C.lds + TAB_OFF + 34 * 4;
    LAS int* cnts = (LAS int*)(C.lds + MISC_OFF + 128);
    if (C.tid < 32) cnts[C.tid] = (int)__hip_atomic_load(C.ctl + CW_CNT + 64 * C.tid, RLX_AGENT);
    __syncthreads();
    if (C.tid == 0) { int off = 0, nt = 0;
        for (int e = 0; e < 32; ++e) { const int n = (cnts[e] + 255) >> 8; padoff[e] = off; for (int k = 0; k < n; ++k) tile_e[nt++] = (unsigned char)e; off += n * 256; }
        padoff[32] = off; padoff[33] = nt; }
    __syncthreads();
}
__device__ __forceinline__ void phase_combine(const Ctx& C) {
    moe_tables(C);
    const LAS int* padoff = (const LAS int*)(C.lds + TAB_OFF);
    const bf16* YB = (const bf16*)(C.ws + WS_XG); const int* SEL = (const int*)(C.ws + WS_SEL); const int* SLOT = (const int*)(C.ws + WS_SLOT);
    for (int t = C.gw; t < T; t += C.NGW) {
        int rw[4];
#pragma unroll
        for (int k = 0; k < 4; ++k) rw[k] = padoff[SEL[t * 4 + k]] + SLOT[t * 4 + k];
        GAS f32x4* orow = (GAS f32x4*)(C.out + (size_t)t * DM) + C.lane; const GAS f32x4* xrow = (const GAS f32x4*)((const float*)(C.ws + WS_X1) + (size_t)t * DM) + C.lane;
#pragma unroll
        for (int j = 0; j < 4; ++j) { f32x4 v = xrow[64 * j];
#pragma unroll
            for (int k = 0; k < 4; ++k) { const v2u y = ((const GAS v2u*)(YB + (size_t)rw[k] * DM))[C.lane + 64 * j];
                v.x += bflo(y.x); v.y += bfhi(y.x); v.z += bflo(y.y); v.w += bfhi(y.y); }
            orow[64 * j] = v; }
    }
}
constexpr int N_PHASES = 11;
struct Args { const void* in[22]; float* out; unsigned char* ws; };
template <int LO, int HI>
__global__ void __launch_bounds__(NWAVES * 64, 2) mk_fwd(Args args) {
    extern __shared__ __attribute__((aligned(16))) unsigned char lds[];
    Ctx C;
    C.lds = (LAS unsigned char*)lds; C.ws = args.ws; C.ctl = (gu32*)(args.ws + WS_CTL); C.in = args.in; C.out = args.out;
    C.tid = ltid(); C.lane = C.tid & 63; C.wave = __builtin_amdgcn_readfirstlane((int)threadIdx.x >> 6);
    C.G = gridDim.x; { const int bx = blockIdx.x; C.vcu = (C.G % 8 == 0) ? (bx % 8) * (C.G / 8) + bx / 8 : bx; }
    C.gw = C.vcu * NWAVES + C.wave; C.NGW = C.G * NWAVES;
    volatile LAS unsigned* MISC = (volatile LAS unsigned*)(C.lds + MISC_OFF);
    if (C.tid < 32) MISC[C.tid] = 0u;
    __syncthreads();
    XcdBarrier bar; bar.bar = (unsigned*)(C.ctl + CW_BAR); bar.x = 0; bar.st = nullptr;
    if (HI - LO > 1) bar = xcd_barrier_post((unsigned*)(C.ctl + CW_BAR), MISC + 8);
#define GRID_BAR() xcd_barrier(bar)
#ifdef PH_ONLY
#define IN(k) ((k) == PH_ONLY && LO <= (k) && (k) < HI)
#else
#define IN(k) (LO <= (k) && (k) < HI)
#endif
#define SEAM(k) do { if (IN(k) && IN((k) + 1)) GRID_BAR(); C.tid = ltid(); C.lane = C.tid & 63; } while (0)
    if (IN(0)) { phase_prologue(C); SEAM(0); }
    if (IN(1)) {
        pg8::Gemm g{(const bf16*)(C.ws + WS_XN), (const bf16*)(C.ws + WS_WIN), T, NPROJ, DM}; pg8::StaticOrder S; S.init(T, NPROJ, C.G, (int)blockIdx.x);
        pg8::EpiStoreBf16 E{(bf16*)(C.ws + WS_PROJ), NPROJ};
        pg8::gemm_phase<pg8::EpiStoreBf16, pg8::StaticOrder, true, true>(C.lds + RING_OFF, g, S, E);
        SEAM(1);
    }
    if (IN(2)) { phase_qk(C); SEAM(2); }
    if (IN(3)) { phase_mix(C, lds, 0); SEAM(3); }
    if (IN(4)) { phase_scan(C); SEAM(4); }
    if (IN(5)) { phase_mix(C, lds, 1); SEAM(5); }
    if (IN(6)) {
        pg8::Gemm g{(const bf16*)(C.ws + WS_MIXED), (const bf16*)(C.ws + WS_WOUT), T, DM, DM}; pg8::StaticOrder S; S.init(T, DM, C.G, (int)blockIdx.x);
        pg8::EpiResF32 E{(const float*)C.in[0], (float*)(C.ws + WS_X1), DM};
        pg8::gemm_phase<pg8::EpiResF32, pg8::StaticOrder, true, true>(C.lds + RING_OFF, g, S, E);
        SEAM(6);
    }
    if (IN(7)) { phase_route(C); SEAM(7); }
    if (IN(8)) {
        moe_tables(C);
        const LAS int* padoff = (const LAS int*)(C.lds + TAB_OFF);
        pg8::Gemm g{(const bf16*)(C.ws + WS_H2), (const bf16*)(C.ws + WS_W1), MAXROWS, NEXP * 2048, DM};
        pg8::MoeGatherOrder S{padoff[33] * 8, 8, C.G, C.vcu, (const LAS unsigned char*)(C.lds + TAB_OFF + 34 * 4), padoff, (const LAS int*)(C.lds + MISC_OFF + 128), (const int*)(C.ws + WS_TOKE), DM * 2};
        pg8::EpiSwiglu E{(bf16*)(C.ws + WS_ACT), (const float*)C.in[19]};
        pg8::gemm_phase<pg8::EpiSwiglu, pg8::MoeGatherOrder, true, true>(C.lds + RING_OFF, g, S, E);
        SEAM(8);
    }
    if (IN(9)) {
        moe_tables(C);
        const LAS int* padoff = (const LAS int*)(C.lds + TAB_OFF);
        pg8::Gemm g{(const bf16*)(C.ws + WS_ACT), (const bf16*)(C.ws + WS_W2), MAXROWS, NEXP * 1024, DFF};
        pg8::MoeOrder S{padoff[33] * 4, 4, C.G, C.vcu, (const LAS unsigned char*)(C.lds + TAB_OFF + 34 * 4)};
        pg8::EpiGateBf16 E{(bf16*)(C.ws + WS_XG), (const float*)C.in[21], (const float*)(C.ws + WS_GATEE), padoff, (const LAS int*)(C.lds + MISC_OFF + 128)};
        pg8::gemm_phase<pg8::EpiGateBf16, pg8::MoeOrder, true, true>(C.lds + RING_OFF, g, S, E);
        SEAM(9);
    }
    if (IN(10)) { phase_combine(C); }
#undef IN
#undef SEAM
}

template <int LO, int HI> static void launch_range(int grid, const Args& a, hipStream_t stream) {
    static bool attr_set = false;
    if (!attr_set) { if (hipFuncSetAttribute((const void*)mk_fwd<LO, HI>, hipFuncAttributeMaxDynamicSharedMemorySize, LDS_BYTES) != hipSuccess) fprintf(stderr, "kernel_launch: hipFuncSetAttribute failed\n"); attr_set = true; }
    hipLaunchKernelGGL((mk_fwd<LO, HI>), dim3(grid), dim3(NWAVES * 64), LDS_BYTES, stream, a);
}
extern "C" void kernel_launch(void* const* d_in, const int* in_sizes, int n_in, void* d_out, int out_size, void* d_ws, size_t ws_size, hipStream_t stream) {
    static int grid = 0;
    if (grid == 0) {
        if (n_in != 22 || in_sizes[0] != T * DM || out_size != T * DM || ws_size < WS_END) {
            fprintf(stderr, "kernel_launch: shape mismatch (n_in %d, in0 %d, out %d, ws %zu; need ws >= %zu); nothing launched\n", n_in, n_in > 0 ? in_sizes[0] : -1, out_size, ws_size, (size_t)WS_END); grid = -1; return; }
        int dev = 0, cus = 0;
        if (hipGetDevice(&dev) != hipSuccess || hipDeviceGetAttribute(&cus, hipDeviceAttributeMultiprocessorCount, dev) != hipSuccess) { fprintf(stderr, "kernel_launch: device query failed\n"); grid = -1; return; }
        if (cus < 256) { fprintf(stderr, "kernel_launch: built for a 256-CU device (found %d CUs); nothing launched\n", cus); grid = -1; return; }
        grid = 256;
    }
    if (grid < 0) return;
    if (hipMemsetAsync((char*)d_ws + WS_CTL, 0, CTL_ZERO_BYTES, stream) != hipSuccess) { fprintf(stderr, "kernel_launch: memset failed\n"); return; }
    Args a{};
    for (int i = 0; i < 22; ++i) a.in[i] = d_in[i];
    a.out = (float*)d_out; a.ws = (unsigned char*)d_ws;
#if MK_SPLIT
#ifndef DUP_MASK
#define DUP_MASK 0
#endif
#define LP(k) do { launch_range<(k), (k) + 1>(grid, a, stream); if ((DUP_MASK >> (k)) & 1) launch_range<(k), (k) + 1>(grid, a, stream); } while (0)
    LP(0); LP(1); LP(2); LP(3); LP(4); LP(5); LP(6); LP(7); LP(8); LP(9); LP(10);
#else
    launch_range<0, N_PHASES>(grid, a, stream);
#endif
    const hipError_t le = hipPeekAtLastError();
    if (le != hipSuccess) fprintf(stderr, "kernel_launch: launch failed: %s\n", hipGetErrorName(le));
}
```
